# Optimizing an MI355X kernel written in HIP

```python
import math
import jax, jax.numpy as jnp
from jax import lax
import numpy as np

D_MODEL = 2048
BATCH = 4
SEQ = 4096
DEPTH = 1

HEAD_DIM = 128
Q_BLOCK = 128
A_Q_HEADS = 8
A_KV_HEADS = 2
A_REP = A_Q_HEADS // A_KV_HEADS
ROPE_THETA = 10000.0
ROPE_AXIS_DIM = HEAD_DIM // 2
GRID_W = 64
B_WINDOWS = (128, 512, 2048)
B_DILATIONS = (1, 4, 16)
B_GROUPS = 3
B_HEADS_PER_GROUP = 4
B_HEADS = B_GROUPS * B_HEADS_PER_GROUP
B_SIDE = B_WINDOWS[0] // (2 * B_DILATIONS[0])
B_KEYS = 2 * B_SIDE + 1
A_Q_W = A_Q_HEADS * HEAD_DIM
A_KV_W = A_KV_HEADS * HEAD_DIM
B_W = B_HEADS * HEAD_DIM
IN_WIDTHS = (A_Q_W, A_KV_W, A_KV_W, B_W, B_W, B_W, D_MODEL, D_MODEL)
IN_TOTAL = A_Q_W + 2 * A_KV_W + 3 * B_W + 2 * D_MODEL
A_OUT_W = A_Q_W
B_OUT_W = B_HEADS_PER_GROUP * HEAD_DIM
FFN_HIDDEN = -(-8 * D_MODEL // (3 * 256)) * 256
ALPHA = (2.0 * DEPTH) ** 0.25
BETA = (8.0 * DEPTH) ** -0.25
RMS_EPS = 1e-6
LN_EPS = 1e-5

kernel_name = 'hybrid_gqa_axialrope_dilated_alibi_deepnorm_swiglu'


def _layer_norm(x, g, b):
    x32 = x.astype(jnp.float32)
    mu = jnp.mean(x32, axis=-1, keepdims=True)
    var = jnp.mean(jnp.square(x32 - mu), axis=-1, keepdims=True)
    y = (x32 - mu) * lax.rsqrt(var + LN_EPS) * g.astype(jnp.float32) + b.astype(jnp.float32)
    return y.astype(x.dtype)


def _rms_norm(x, g):
    x32 = x.astype(jnp.float32)
    y = x32 * lax.rsqrt(jnp.mean(jnp.square(x32), axis=-1, keepdims=True) + RMS_EPS)
    return (y * g.astype(jnp.float32)).astype(x.dtype)


def _axial_rope_tables(seq_len):
    rows = seq_len // GRID_W
    row_id = jnp.broadcast_to(jnp.arange(rows)[:, None], (rows, GRID_W)).reshape(-1)
    col_id = jnp.broadcast_to(jnp.arange(GRID_W)[None, :], (rows, GRID_W)).reshape(-1)
    n_freq = ROPE_AXIS_DIM // 2
    freqs = ROPE_THETA ** (-jnp.arange(n_freq, dtype=jnp.float32) / n_freq)
    ang_r = row_id.astype(jnp.float32)[:, None] * freqs[None, :]
    ang_c = col_id.astype(jnp.float32)[:, None] * freqs[None, :]
    return (jnp.cos(ang_r), jnp.sin(ang_r), jnp.cos(ang_c), jnp.sin(ang_c))


def _rotate_half(xh, cos, sin):
    x1, x2 = jnp.split(xh, 2, axis=-1)
    c = cos[None, :, None, :]
    s = sin[None, :, None, :]
    return jnp.concatenate([x1 * c - x2 * s, x2 * c + x1 * s], axis=-1)


def _apply_axial_rope(x, tabs):
    cos_r, sin_r, cos_c, sin_c = tabs
    xr = _rotate_half(x[..., :ROPE_AXIS_DIM], cos_r, sin_r)
    xc = _rotate_half(x[..., ROPE_AXIS_DIM:], cos_c, sin_c)
    return jnp.concatenate([xr, xc], axis=-1).astype(x.dtype)


def _gqa_blocks(q, k, v):
    bsz, seq_len = q.shape[0], q.shape[1]
    nb = seq_len // Q_BLOCK
    qb = q.reshape(bsz, nb, Q_BLOCK, A_KV_HEADS, A_REP, HEAD_DIM).swapaxes(0, 1)

    def one_block(qblk):
        s = jnp.einsum('bqgrd,bkgd->bgrqk', qblk, k, preferred_element_type=jnp.float32)
        p = jax.nn.softmax(s, axis=-1)
        return jnp.einsum('bgrqk,bkgd->bqgrd', p.astype(v.dtype), v)

    o = lax.map(one_block, qb)
    return o.swapaxes(0, 1).reshape(bsz, seq_len, A_OUT_W)


def _dilated_offsets():
    side = jnp.arange(-B_SIDE, B_SIDE + 1, dtype=jnp.int32)
    return jnp.stack([dil * side for dil in B_DILATIONS], axis=0)


def _alibi_slopes():
    i = jnp.arange(1, B_HEADS + 1, dtype=jnp.float32)
    return (2.0 ** (-8.0 * i / B_HEADS)).reshape(B_GROUPS, B_HEADS_PER_GROUP)


def _dilated_window_attention(q, k, v):
    bsz, seq_len = q.shape[0], q.shape[1]
    nb = seq_len // Q_BLOCK
    offs = _dilated_offsets()
    bias = -_alibi_slopes()[:, :, None] * jnp.abs(offs).astype(jnp.float32)[:, None, :]
    g_idx = jnp.arange(B_GROUPS)[None, :, None]

    def one_block(n):
        t = n * Q_BLOCK + jnp.arange(Q_BLOCK)
        pos = t[:, None, None] + offs[None, :, :]
        valid = (pos >= 0) & (pos < seq_len)
        pos_c = jnp.clip(pos, 0, seq_len - 1)
        qblk = lax.dynamic_slice_in_dim(q, n * Q_BLOCK, Q_BLOCK, axis=1)
        ks = k[:, pos_c, g_idx]
        vs = v[:, pos_c, g_idx]
        s = jnp.einsum('bqghd,bqgjhd->bqghj', qblk, ks, preferred_element_type=jnp.float32) + bias
        s = jnp.where(valid[None, :, :, None, :], s, -jnp.inf)
        lse = jax.nn.logsumexp(s, axis=-1, keepdims=True)
        p = jnp.exp(s - lse)
        o = jnp.einsum('bqghj,bqgjhd->bqghd', p.astype(v.dtype), vs)
        w = jax.nn.softmax(lse[..., 0], axis=2)
        return jnp.einsum('bqgh,bqghd->bqhd', w.astype(o.dtype), o)

    o = lax.map(one_block, jnp.arange(nb))
    return o.swapaxes(0, 1).reshape(bsz, seq_len, B_OUT_W)


def _hybrid_layer(x, w_in, b_gate, q_norm_a, k_norm_a, w_proj_a, w_proj_b, w_out,
                  ln1_g, ln1_b, w_ffn_gate, w_ffn_up, w_ffn_down, ln2_g, ln2_b, rope_tabs):
    bsz, seq_len, _ = x.shape
    scale = HEAD_DIM ** -0.5
    split_pts = [int(p) for p in np.cumsum(IN_WIDTHS)[:-1]]
    qa, ka, va, qb, kb, vb, ga, gb = jnp.split(x @ w_in, split_pts, axis=-1)
    qa = _apply_axial_rope(_rms_norm(qa.reshape(bsz, seq_len, A_Q_HEADS, HEAD_DIM), q_norm_a), rope_tabs)
    ka = _apply_axial_rope(_rms_norm(ka.reshape(bsz, seq_len, A_KV_HEADS, HEAD_DIM), k_norm_a), rope_tabs)
    va = va.reshape(bsz, seq_len, A_KV_HEADS, HEAD_DIM)
    out_a = _gqa_blocks(qa * scale, ka, va)
    shp = (bsz, seq_len, B_GROUPS, B_HEADS_PER_GROUP, HEAD_DIM)
    out_b = _dilated_window_attention(qb.reshape(shp) * scale, kb.reshape(shp), vb.reshape(shp))
    gate_a = jax.nn.sigmoid(ga + b_gate[0])
    gate_b = jax.nn.sigmoid(gb + b_gate[1])
    mixed = (gate_a * (out_a @ w_proj_a) + gate_b * (out_b @ w_proj_b)) @ w_out
    x = _layer_norm(ALPHA * x + mixed, ln1_g, ln1_b)
    h = jax.nn.silu(x @ w_ffn_gate) * (x @ w_ffn_up)
    x = _layer_norm(ALPHA * x + h @ w_ffn_down, ln2_g, ln2_b)
    return x


def setup_inputs(seed: int = 0) -> dict:
    key = jax.random.key(seed)
    ks = jax.random.split(key, 16)
    f32 = jnp.float32

    def nrm(k, shape, fan_in, s=1.0):
        return jax.random.normal(k, shape, f32) * (s * fan_in ** -0.5)

    col_scale = jnp.concatenate([jnp.full((w,), sc, f32) for w, sc in
                                 zip(IN_WIDTHS, (1.0, 1.0, BETA, 1.0, 1.0, BETA, 1.0, 1.0))])
    return {
        'x': jax.random.normal(ks[0], (BATCH, SEQ, D_MODEL), f32),
        'w_in': nrm(ks[1], (DEPTH, D_MODEL, IN_TOTAL), D_MODEL) * col_scale,
        'b_gate': 0.02 * jax.random.normal(ks[2], (DEPTH, 2, D_MODEL), f32),
        'q_norm_a': 1.0 + 0.02 * jax.random.normal(ks[3], (DEPTH, HEAD_DIM), f32),
        'k_norm_a': 1.0 + 0.02 * jax.random.normal(ks[4], (DEPTH, HEAD_DIM), f32),
        'w_proj_a': nrm(ks[5], (DEPTH, A_OUT_W, D_MODEL), A_OUT_W, BETA),
        'w_proj_b': nrm(ks[6], (DEPTH, B_OUT_W, D_MODEL), B_OUT_W, BETA),
        'w_out': nrm(ks[7], (DEPTH, D_MODEL, D_MODEL), D_MODEL, BETA),
        'ln1_g': 1.0 + 0.02 * jax.random.normal(ks[8], (DEPTH, D_MODEL), f32),
        'ln1_b': 0.02 * jax.random.normal(ks[9], (DEPTH, D_MODEL), f32),
        'w_ffn_gate': nrm(ks[10], (DEPTH, D_MODEL, FFN_HIDDEN), D_MODEL),
        'w_ffn_up': nrm(ks[11], (DEPTH, D_MODEL, FFN_HIDDEN), D_MODEL),
        'w_ffn_down': nrm(ks[12], (DEPTH, FFN_HIDDEN, D_MODEL), FFN_HIDDEN, BETA),
        'ln2_g': 1.0 + 0.02 * jax.random.normal(ks[13], (DEPTH, D_MODEL), f32),
        'ln2_b': 0.02 * jax.random.normal(ks[14], (DEPTH, D_MODEL), f32),
    }


def reference(x, w_in, b_gate, q_norm_a, k_norm_a, w_proj_a, w_proj_b, w_out,
              ln1_g, ln1_b, w_ffn_gate, w_ffn_up, w_ffn_down, ln2_g, ln2_b):
    rope_tabs = _axial_rope_tables(x.shape[1])
    for l in range(DEPTH):
        x = _hybrid_layer(x, w_in[l], b_gate[l], q_norm_a[l], k_norm_a[l], w_proj_a[l], w_proj_b[l],
                          w_out[l], ln1_g[l], ln1_b[l], w_ffn_gate[l], w_ffn_up[l], w_ffn_down[l],
                          ln2_g[l], ln2_b[l], rope_tabs)
    return x
```

```cpp
#include <hip/hip_runtime.h>
#include <hip/hip_bf16.h>
#include <hip/hip_cooperative_groups.h>
#include <cstdio>
#include <cstdint>
#include <cmath>
namespace cg = cooperative_groups;
namespace pg8 {
#define PG8_LAS __attribute__((address_space(3)))
typedef unsigned short bf16_t;
typedef short bf16x8 __attribute__((ext_vector_type(8)));
typedef float f32x4 __attribute__((ext_vector_type(4)));
typedef unsigned u32x4 __attribute__((ext_vector_type(4)));
constexpr int BM = 256, BK = 64, HALF = 128, HTB = HALF * BK * 2  , STAGE_BYTES = 8 * HTB, NXCD = 8, WGM = 8;

__host__ __device__ __forceinline__ int lds_byte(int r, int c) { const int st = (r >> 4) * 2 + (c >> 5), rr = r & 15, cc = c & 31, ob = rr * 64 + cc * 2; return st * 1024 + (ob ^ (((ob >> 9) & 1) << 5)); }
__host__ __device__ __forceinline__ void stage_rc(int b, int& R, int& C) { const int st = b / 1024, sb = b % 1024, swz = sb ^ (((sb >> 9) & 1) << 5); R = (st >> 1) * 16 + swz / 64; C = (st & 1) * 32 + (swz % 64) / 2; }
__host__ __device__ __forceinline__ int perm32(int rho) { const int n = rho >> 4, i = rho & 15; return 8 * (i >> 2) + 4 * n + (i & 3); }

struct Unit { int pm, pn; };
struct Gemm { const bf16_t* A; const bf16_t* Bt; int M, N, K; };

struct StaticOrder {
    int nM, nN, nwg, G, c;
    __host__ __device__ void init(int M, int N, int G_, int c_) { nM = M / BM; nN = N / BM; nwg = nM * nN; G = G_; c = c_; }
    __host__ __device__ bool next(int i, Unit& u) const {
        const long L = (long)i * G + c; if (L >= nwg) return false;
        int wgid = (int)L; { const int q = nwg / NXCD, r = nwg % NXCD, xcd = wgid % NXCD, off = wgid / NXCD; wgid = (xcd < r ? xcd * (q + 1) : r * (q + 1) + (xcd - r) * q) + off; }
        const int nig = WGM * nN, gid = wgid / nig, fm = gid * WGM, gsz = (nM - fm) < WGM ? (nM - fm) : WGM;
        u.pm = fm + ((wgid % nig) % gsz); u.pn = (wgid % nig) / gsz; return true;
    }
    __device__ __forceinline__ void a_ready(const Unit&) const {}
    __device__ __forceinline__ void done(const Unit&) const {}
};

typedef float f32x2_t __attribute__((ext_vector_type(2))); typedef __bf16 bf16x2_t __attribute__((ext_vector_type(2)));
__device__ __forceinline__ unsigned cvt_pk_bf16(float lo, float hi) { f32x2_t v = {lo, hi}; bf16x2_t b = __builtin_convertvector(v, bf16x2_t); return __builtin_bit_cast(unsigned, b); }
typedef float f32x2 __attribute__((ext_vector_type(2)));
typedef unsigned u32x2 __attribute__((ext_vector_type(2)));
__device__ __forceinline__ float sigmoid_f(float x) { return __builtin_amdgcn_rcpf(1.0f + __builtin_amdgcn_exp2f(-1.4426950408889634f * x)); }
__device__ __forceinline__ float bf_lo(unsigned w) { return __uint_as_float(w << 16); }
__device__ __forceinline__ float bf_hi(unsigned w) { return __uint_as_float(w & 0xffff0000u); }

struct EpiQKVG {
    static constexpr bool PERM = true, AFTER_DRAIN = false;
    bf16_t* QKV; bf16_t* G; const float* bgate;
    __device__ __forceinline__ void operator()(const f32x4 (&acc)[2][2][4][2], const Unit& u, int wr, int wc, int fr, int fq) const {
        const int row0 = u.pm * BM + wr * 64 + fr;
        if (u.pn < 24) {
            const int col0 = u.pn * BM + wc * 32 + 8 * fq;
#pragma unroll
            for (int ai = 0; ai < 2; ++ai)
#pragma unroll
                for (int m = 0; m < 4; ++m) { bf16_t* rowp = QKV + (size_t)(row0 + ai * HALF + m * 16) * 6144 + col0;
#pragma unroll
                    for (int bj = 0; bj < 2; ++bj) { const f32x4 v0 = acc[ai][bj][m][0], v1 = acc[ai][bj][m][1];
                        u32x4 w; w.x = cvt_pk_bf16(v0[0], v0[1]); w.y = cvt_pk_bf16(v0[2], v0[3]); w.z = cvt_pk_bf16(v1[0], v1[1]); w.w = cvt_pk_bf16(v1[2], v1[3]);
                        *(u32x4*)(rowp + bj * HALF) = w; } }
        } else {
            const int col0 = (u.pn - 24) * BM + wc * 32 + 8 * fq;
            f32x4 bv[2][2];
#pragma unroll
            for (int bj = 0; bj < 2; ++bj)
#pragma unroll
                for (int n = 0; n < 2; ++n) bv[bj][n] = *(const f32x4*)(bgate + col0 + bj * HALF + 4 * n);
#pragma unroll
            for (int ai = 0; ai < 2; ++ai)
#pragma unroll
                for (int m = 0; m < 4; ++m) { bf16_t* rowp = G + (size_t)(row0 + ai * HALF + m * 16) * 4096 + col0;
#pragma unroll
                    for (int bj = 0; bj < 2; ++bj) { f32x4 v0 = acc[ai][bj][m][0] + bv[bj][0], v1 = acc[ai][bj][m][1] + bv[bj][1];
#pragma unroll
                        for (int e = 0; e < 4; ++e) { v0[e] = sigmoid_f(v0[e]); v1[e] = sigmoid_f(v1[e]); }
                        u32x4 w; w.x = cvt_pk_bf16(v0[0], v0[1]); w.y = cvt_pk_bf16(v0[2], v0[3]); w.z = cvt_pk_bf16(v1[0], v1[1]); w.w = cvt_pk_bf16(v1[2], v1[3]);
                        *(u32x4*)(rowp + bj * HALF) = w; } }
        }
    }
};

struct EpiGateA {
    static constexpr bool PERM = false, AFTER_DRAIN = false;
    float* T; const bf16_t* G;
    __device__ __forceinline__ void operator()(const f32x4 (&acc)[2][2][4][2], const Unit& u, int wr, int wc, int fr, int fq) const {
        const int row0 = u.pm * BM + wr * 64 + fr, col0 = u.pn * BM + wc * 32 + 4 * fq;
#pragma unroll
        for (int ai = 0; ai < 2; ++ai)
#pragma unroll
            for (int m = 0; m < 4; ++m) { const size_t r = (size_t)(row0 + ai * HALF + m * 16);
#pragma unroll
                for (int bj = 0; bj < 2; ++bj)
#pragma unroll
                    for (int n = 0; n < 2; ++n) { const int c = col0 + bj * HALF + n * 16;
                        const u32x2 g = *(const u32x2*)(G + r * 4096 + c); const f32x4 a = acc[ai][bj][m][n];
                        f32x4 o; o[0] = a[0] * bf_lo(g.x); o[1] = a[1] * bf_hi(g.x); o[2] = a[2] * bf_lo(g.y); o[3] = a[3] * bf_hi(g.y);
                        *(f32x4*)(T + r * 2048 + c) = o; }
                if (m & 1) asm volatile("" ::: "memory"); }
    }
};

struct EpiGateB {
    static constexpr bool PERM = true, AFTER_DRAIN = false;
    const float* T; const bf16_t* G; bf16_t* MP;
    __device__ __forceinline__ void operator()(const f32x4 (&acc)[2][2][4][2], const Unit& u, int wr, int wc, int fr, int fq) const {
        const int row0 = u.pm * BM + wr * 64 + fr, col0 = u.pn * BM + wc * 32 + 8 * fq;
#pragma unroll
        for (int ai = 0; ai < 2; ++ai)
#pragma unroll
            for (int m = 0; m < 4; ++m) { const size_t r = (size_t)(row0 + ai * HALF + m * 16);
#pragma unroll
                for (int bj = 0; bj < 2; ++bj) { const int c = col0 + bj * HALF;
                    const u32x4 g = *(const u32x4*)(G + r * 4096 + 2048 + c);
                    const f32x4 t0 = *(const f32x4*)(T + r * 2048 + c), t1 = *(const f32x4*)(T + r * 2048 + c + 4);
                    const f32x4 a0 = acc[ai][bj][m][0], a1 = acc[ai][bj][m][1];
                    u32x4 w;
                    w.x = cvt_pk_bf16(t0[0] + a0[0] * bf_lo(g.x), t0[1] + a0[1] * bf_hi(g.x));
                    w.y = cvt_pk_bf16(t0[2] + a0[2] * bf_lo(g.y), t0[3] + a0[3] * bf_hi(g.y));
                    w.z = cvt_pk_bf16(t1[0] + a1[0] * bf_lo(g.z), t1[1] + a1[1] * bf_hi(g.z));
                    w.w = cvt_pk_bf16(t1[2] + a1[2] * bf_lo(g.w), t1[3] + a1[3] * bf_hi(g.w));
                    *(u32x4*)(MP + r * 2048 + c) = w; }
                if (m & 1) asm volatile("" ::: "memory"); }
    }
};

struct EpiResid {
    static constexpr bool PERM = false, AFTER_DRAIN = false;
    const float* base; float* out; float alpha;
    __device__ __forceinline__ void operator()(const f32x4 (&acc)[2][2][4][2], const Unit& u, int wr, int wc, int fr, int fq) const {
        const int row0 = u.pm * BM + wr * 64 + fr, col0 = u.pn * BM + wc * 32 + 4 * fq;
#pragma unroll
        for (int ai = 0; ai < 2; ++ai)
#pragma unroll
            for (int m = 0; m < 4; ++m) { const size_t r = (size_t)(row0 + ai * HALF + m * 16);
#pragma unroll
                for (int bj = 0; bj < 2; ++bj)
#pragma unroll
                    for (int n = 0; n < 2; ++n) { const int c = col0 + bj * HALF + n * 16;
                        const f32x4 b = *(const f32x4*)(base + r * 2048 + c);
                        *(f32x4*)(out + r * 2048 + c) = b * alpha + acc[ai][bj][m][n]; }
                if (m & 1) asm volatile("" ::: "memory"); }
    }
};

struct EpiSwiGLU {
    static constexpr bool PERM = true, AFTER_DRAIN = false;
    bf16_t* H;
    __device__ __forceinline__ void operator()(const f32x4 (&acc)[2][2][4][2], const Unit& u, int wr, int wc, int fr, int fq) const {
        const int row0 = u.pm * BM + wr * 64 + fr, col0 = u.pn * HALF + wc * 32 + 8 * fq;
#pragma unroll
        for (int ai = 0; ai < 2; ++ai)
#pragma unroll
            for (int m = 0; m < 4; ++m) { bf16_t* rowp = H + (size_t)(row0 + ai * HALF + m * 16) * 5632 + col0;
                f32x4 h0, h1;
#pragma unroll
                for (int e = 0; e < 4; ++e) { const float g0 = acc[ai][0][m][0][e], g1 = acc[ai][0][m][1][e];
                    h0[e] = g0 * sigmoid_f(g0) * acc[ai][1][m][0][e]; h1[e] = g1 * sigmoid_f(g1) * acc[ai][1][m][1][e]; }
                u32x4 w; w.x = cvt_pk_bf16(h0[0], h0[1]); w.y = cvt_pk_bf16(h0[2], h0[3]); w.z = cvt_pk_bf16(h1[0], h1[1]); w.w = cvt_pk_bf16(h1[2], h1[3]);
                *(u32x4*)rowp = w; }
    }
};

template <class Epi, class Sched, bool ALIGN_EPI = false, bool SP2 = false>
__device__ __forceinline__ void gemm_phase(PG8_LAS unsigned char* lds, const Gemm g, const Sched& S, const Epi& E, const int tid  ) {
    const int wid = __builtin_amdgcn_readfirstlane(tid >> 6), lane = tid & 63, wr = wid >> 2, wc = wid & 3, fr = lane & 15, fq = lane >> 4;
    const int K = g.K, nt = K / BK;
    unsigned voffA[2], voffB[2];
#pragma unroll
    for (int i = 0; i < 2; ++i) { int R, C; stage_rc(tid * 16 + i * 8192, R, C); const int Rb = Epi::PERM ? ((R & ~31) + perm32(R & 31)) : R;
        voffA[i] = (unsigned)(R * K + C) * 2u; voffB[i] = (unsigned)(Rb * K + C) * 2u; }
    const size_t kstep = (size_t)(BK * 2);
    const size_t hstep = (size_t)HALF * K * 2;
    const size_t tstep = 2 * hstep;
    const unsigned ldsw = (unsigned)wid * 1024u;
    const int aoff = lds_byte(wr * 64 + fr, fq * 8), boff = lds_byte(wc * 32 + fr, fq * 8);
#define PG8_SA(b, h) (((b) * 2 + (h)) * HTB)
#define PG8_SB(b, h) ((4 + (b) * 2 + (h)) * HTB)
#define PG8_STAGE(bufoff, gbase, voff) do { _Pragma("unroll") for (int _i = 0; _i < 2; ++_i) \
        __builtin_amdgcn_global_load_lds((const unsigned*)((const char*)(gbase) + (voff)[_i]), (PG8_LAS unsigned*)(lds + (bufoff) + ldsw + _i * 8192), 16, 0, 0); } while (0)
#define PG8_LDA(dst, b, h) do { _Pragma("unroll") for (int m = 0; m < 4; ++m) _Pragma("unroll") for (int k = 0; k < 2; ++k) dst[m][k] = *(const PG8_LAS bf16x8*)(lds + PG8_SA(b, h) + aoff + m * 2048 + k * 1024); } while (0)
#define PG8_LDB(dst, b, h) do { _Pragma("unroll") for (int n = 0; n < 2; ++n) _Pragma("unroll") for (int k = 0; k < 2; ++k) dst[n][k] = *(const PG8_LAS bf16x8*)(lds + PG8_SB(b, h) + boff + n * 2048 + k * 1024); } while (0)
#define PG8_MMA(ai, bj, At, Bt) do { __builtin_amdgcn_s_setprio(1); _Pragma("unroll") for (int m = 0; m < 4; ++m) _Pragma("unroll") for (int n = 0; n < 2; ++n) _Pragma("unroll") for (int k = 0; k < 2; ++k) \
        acc[ai][bj][m][n] = __builtin_amdgcn_mfma_f32_16x16x32_bf16(Bt[n][k], At[m][k], acc[ai][bj][m][n], 0, 0, 0); __builtin_amdgcn_s_setprio(0); } while (0)
#define PG8_WAIT_V(n) asm volatile("s_waitcnt vmcnt(" #n ")" ::: "memory")
#define PG8_WAIT_L(n) asm volatile("s_waitcnt lgkmcnt(" #n ")" ::: "memory")
#define PG8_BAR __builtin_amdgcn_s_barrier()
#define PG8_SCHED __builtin_amdgcn_sched_barrier(0)
    Unit cur, nxt; int ui = 0;
    if (!S.next(0, cur)) return;
    f32x4 acc[2][2][4][2];
#pragma unroll
    for (int a = 0; a < 2; ++a)
#pragma unroll
        for (int b = 0; b < 2; ++b)
#pragma unroll
            for (int m = 0; m < 4; ++m)
#pragma unroll
                for (int n = 0; n < 2; ++n) acc[a][b][m][n] = (f32x4){0.f, 0.f, 0.f, 0.f};
    bf16x8 At[4][2], B0[2][2], B1[2][2];
    const char* cA = (const char*)g.A + (size_t)cur.pm * tstep; const char* cB = (const char*)g.Bt + (size_t)cur.pn * tstep;
    S.a_ready(cur);
    if constexpr (SP2) {
        PG8_STAGE(PG8_SB(0, 0), cB, voffB); PG8_STAGE(PG8_SB(0, 1), cB + hstep, voffB); PG8_STAGE(PG8_SA(0, 0), cA, voffA); PG8_STAGE(PG8_SA(0, 1), cA + hstep, voffA);
        if (wr == 1) PG8_BAR;
        PG8_WAIT_V(2); PG8_BAR;
        PG8_STAGE(PG8_SB(1, 0), cB + kstep, voffB); PG8_STAGE(PG8_SA(1, 0), cA + kstep, voffA); PG8_STAGE(PG8_SB(1, 1), cB + hstep + kstep, voffB);
        PG8_WAIT_V(6); PG8_BAR;
    } else {
        PG8_STAGE(PG8_SB(0, 0), cB, voffB); PG8_STAGE(PG8_SA(0, 0), cA, voffA); PG8_STAGE(PG8_SB(0, 1), cB + hstep, voffB); PG8_STAGE(PG8_SA(0, 1), cA + hstep, voffA);
        if (wr == 1) PG8_BAR;
        PG8_WAIT_V(4); PG8_BAR;
        PG8_STAGE(PG8_SB(1, 0), cB + kstep, voffB); PG8_STAGE(PG8_SA(1, 0), cA + kstep, voffA); PG8_STAGE(PG8_SB(1, 1), cB + hstep + kstep, voffB);
        PG8_WAIT_V(6); PG8_BAR;
    }
    for (;;) {
        const bool has_next = S.next(ui + 1, nxt);
        const char* nA = has_next ? (const char*)g.A + (size_t)nxt.pm * tstep : cA; const char* nB = has_next ? (const char*)g.Bt + (size_t)nxt.pn * tstep : cB;
        for (int t = 0; t < nt; t += 2) {
            const bool last = (t == nt - 2);
            const char* a1 = cA + (size_t)(t + 1) * kstep;
            const char* a2 = last ? nA : cA + (size_t)(t + 2) * kstep; const char* b2 = last ? nB : cB + (size_t)(t + 2) * kstep;
            const char* a3 = a2 + kstep; const char* b3 = b2 + kstep;
            if (last && has_next) S.a_ready(nxt);
            if constexpr (SP2) {
            PG8_LDB(B0, 0, 0); PG8_LDB(B1, 0, 1); PG8_SCHED; PG8_LDA(At, 0, 0); PG8_STAGE(PG8_SA(1, 1), a1 + hstep, voffA);
            PG8_WAIT_V(8); PG8_WAIT_L(0); PG8_BAR; PG8_MMA(0, 0, At, B0); PG8_MMA(0, 1, At, B1); PG8_BAR; PG8_SCHED;
            PG8_LDA(At, 0, 1); PG8_STAGE(PG8_SB(0, 0), b2, voffB); PG8_STAGE(PG8_SB(0, 1), b2 + hstep, voffB); PG8_STAGE(PG8_SA(0, 0), a2, voffA);
            PG8_WAIT_V(8); PG8_WAIT_L(0); PG8_BAR; PG8_MMA(1, 0, At, B0); PG8_MMA(1, 1, At, B1); PG8_BAR; PG8_SCHED;
            PG8_LDB(B0, 1, 0); PG8_LDB(B1, 1, 1); PG8_SCHED; PG8_LDA(At, 1, 0); PG8_STAGE(PG8_SA(0, 1), a2 + hstep, voffA);
            PG8_WAIT_V(8); PG8_WAIT_L(0); PG8_BAR; PG8_MMA(0, 0, At, B0); PG8_MMA(0, 1, At, B1); PG8_BAR; PG8_SCHED;
            PG8_LDA(At, 1, 1); PG8_STAGE(PG8_SB(1, 0), b3, voffB); PG8_STAGE(PG8_SB(1, 1), b3 + hstep, voffB); PG8_STAGE(PG8_SA(1, 0), a3, voffA);
            PG8_WAIT_V(8); PG8_WAIT_L(0); PG8_BAR; PG8_MMA(1, 0, At, B0); PG8_MMA(1, 1, At, B1); PG8_BAR; PG8_SCHED;
            } else {
            PG8_LDB(B0, 0, 0); PG8_SCHED; PG8_LDA(At, 0, 0); PG8_STAGE(PG8_SA(1, 1), a1 + hstep, voffA);
            PG8_WAIT_L(8); PG8_BAR; PG8_WAIT_L(0); PG8_MMA(0, 0, At, B0); PG8_BAR; PG8_SCHED;
            PG8_LDB(B1, 0, 1); PG8_STAGE(PG8_SB(0, 0), b2, voffB);
            PG8_BAR; PG8_WAIT_L(0); PG8_MMA(0, 1, At, B1); PG8_BAR;
            PG8_LDA(At, 0, 1); PG8_STAGE(PG8_SA(0, 0), a2, voffA);
            PG8_BAR; PG8_WAIT_L(0); PG8_MMA(1, 0, At, B0); PG8_BAR; PG8_SCHED;
            PG8_STAGE(PG8_SB(0, 1), b2 + hstep, voffB);
            PG8_WAIT_V(6); PG8_BAR; PG8_MMA(1, 1, At, B1); PG8_BAR;
            PG8_LDB(B0, 1, 0); PG8_SCHED; PG8_LDA(At, 1, 0); PG8_STAGE(PG8_SA(0, 1), a2 + hstep, voffA);
            PG8_WAIT_L(8); PG8_BAR; PG8_WAIT_L(0); PG8_MMA(0, 0, At, B0); PG8_BAR; PG8_SCHED;
            PG8_LDB(B1, 1, 1); PG8_STAGE(PG8_SB(1, 0), b3, voffB);
            PG8_BAR; PG8_WAIT_L(0); PG8_MMA(0, 1, At, B1); PG8_BAR;
            PG8_LDA(At, 1, 1); PG8_STAGE(PG8_SA(1, 0), a3, voffA);
            PG8_BAR; PG8_WAIT_L(0); PG8_MMA(1, 0, At, B0); PG8_BAR; PG8_SCHED;
            PG8_STAGE(PG8_SB(1, 1), b3 + hstep, voffB);
            PG8_WAIT_V(6); PG8_BAR; PG8_MMA(1, 1, At, B1); PG8_BAR;
            }
        }
        if constexpr (ALIGN_EPI) { if (wr == 0) PG8_BAR; }
        if constexpr (!Epi::AFTER_DRAIN) { E(acc, cur, wr, wc, fr, fq); S.done(cur); }
        if (!has_next) break;
#pragma unroll
        for (int a = 0; a < 2; ++a)
#pragma unroll
            for (int b = 0; b < 2; ++b)
#pragma unroll
                for (int m = 0; m < 4; ++m)
#pragma unroll
                    for (int n = 0; n < 2; ++n) acc[a][b][m][n] = (f32x4){0.f, 0.f, 0.f, 0.f};
        cur = nxt; cA = nA; cB = nB; ++ui;
        if constexpr (ALIGN_EPI) { if (wr == 1) PG8_BAR; }
    }
    PG8_WAIT_V(0);
    if constexpr (!ALIGN_EPI) { if (wr == 0) PG8_BAR; }
    PG8_BAR;
    if constexpr (Epi::AFTER_DRAIN) { E.fused(acc, cur, wr, wc, fr, fq, lds, wid, lane); S.done(cur); }
#undef PG8_SA
#undef PG8_SB
#undef PG8_STAGE
#undef PG8_LDA
#undef PG8_LDB
#undef PG8_MMA
#undef PG8_WAIT_V
#undef PG8_WAIT_L
#undef PG8_BAR
#undef PG8_SCHED
}
}

#ifndef PG8_SP2
#define PG8_SP2 true
#endif
namespace att {
using bf16 = __hip_bfloat16;
constexpr int D = 128, NW = 8, QBLK = 32, KVBLK = 64;
constexpr float SCALE = 0.088388347648318440f;
constexpr float THR = 8.f;
constexpr float LOG2E = 1.4426950408889634f;
constexpr size_t SHM_V = KVBLK * D * 2, SHM_K = KVBLK * D * 2, SHM_ATTN = 2 * SHM_V + 2 * SHM_K + NW * 64 * 4;
using bf16x8 = __attribute__((ext_vector_type(8))) short;
using s16x4  = __attribute__((ext_vector_type(4))) short;
using f32x16 = __attribute__((ext_vector_type(16))) float;
using u32x4  = __attribute__((ext_vector_type(4))) unsigned;
#define KSWZ(row, colB) ((row) * 256 + ((colB) ^ (((row) & 7) << 4)))
#define SBAR() __builtin_amdgcn_sched_barrier(0)
__device__ __forceinline__ int crow(int r, int hi) { return (r & 3) + 8 * (r >> 2) + 4 * hi; }
__device__ __forceinline__ unsigned cvtpk(float lo, float hi) { return pg8::cvt_pk_bf16(lo, hi); }
__device__ __forceinline__ void partialSM(f32x16& p0, f32x16& p1, float& m_reg, float& mn, float& alpha) {
  constexpr float C = SCALE * LOG2E;
  float pmax = p0[0]; for (int r = 1; r < 16; ++r) pmax = fmaxf(pmax, p0[r]); for (int r = 0; r < 16; ++r) pmax = fmaxf(pmax, p1[r]);
  { auto rr = __builtin_amdgcn_permlane32_swap(__float_as_uint(pmax), __float_as_uint(pmax), false, false);
    pmax = fmaxf(__uint_as_float(rr[0]), __uint_as_float(rr[1])); }
  if (__builtin_expect(__all(pmax - m_reg <= THR / SCALE), 1)) { mn = m_reg; alpha = 1.f; }
  else { mn = fmaxf(m_reg, pmax); alpha = __builtin_amdgcn_exp2f((m_reg - mn) * C); m_reg = mn; }
  float mnC = -mn * C;
  for (int r = 0; r < 16; ++r) p0[r] = fmaf(p0[r], C, mnC); for (int r = 0; r < 16; ++r) p1[r] = fmaf(p1[r], C, mnC);
  for (int r = 0; r < 16; ++r) p0[r] = __builtin_amdgcn_exp2f(p0[r]);
}
__device__ __forceinline__ void partialSM_win(f32x16& p0, f32x16& p1, float& m_reg, float& mn, float& alpha, float ef, float slope2) {
  constexpr float C = SCALE * LOG2E;
#pragma unroll
  for (int r = 0; r < 16; ++r) { const float o0 = (float)((r & 3) + 8 * (r >> 2));
    const float d0 = fabsf(ef + o0), d1 = fabsf(ef + (o0 + 32.f));
    const float t0 = fmaf(p0[r], C, -slope2 * d0), t1 = fmaf(p1[r], C, -slope2 * d1);
    p0[r] = d0 > 64.5f ? -1e30f : t0; p1[r] = d1 > 64.5f ? -1e30f : t1; }
  float pmax = p0[0]; for (int r = 1; r < 16; ++r) pmax = fmaxf(pmax, p0[r]); for (int r = 0; r < 16; ++r) pmax = fmaxf(pmax, p1[r]);
  { auto rr = __builtin_amdgcn_permlane32_swap(__float_as_uint(pmax), __float_as_uint(pmax), false, false);
    pmax = fmaxf(__uint_as_float(rr[0]), __uint_as_float(rr[1])); }
  if (__builtin_expect(__all(pmax - m_reg <= THR * LOG2E), 1)) { mn = m_reg; alpha = 1.f; }
  else { mn = fmaxf(m_reg, pmax); alpha = __builtin_amdgcn_exp2f(m_reg - mn); m_reg = mn; }
  for (int r = 0; r < 16; ++r) p0[r] = p0[r] - mn; for (int r = 0; r < 16; ++r) p1[r] = p1[r] - mn;
  for (int r = 0; r < 16; ++r) p0[r] = __builtin_amdgcn_exp2f(p0[r]);
}
__device__ __forceinline__ void finishSM(f32x16& p0, f32x16& p1, float alpha, float& l_reg, bf16x8& pa0, bf16x8& pa1, bf16x8& pa2, bf16x8& pa3) {
  for (int r = 0; r < 16; ++r) p1[r] = __builtin_amdgcn_exp2f(p1[r]);
  float ps = 0; for (int r = 0; r < 16; ++r) ps += p0[r]; for (int r = 0; r < 16; ++r) ps += p1[r];
  { auto rr = __builtin_amdgcn_permlane32_swap(__float_as_uint(ps), __float_as_uint(ps), false, false);
    ps = __uint_as_float(rr[0]) + __uint_as_float(rr[1]); }
  l_reg = l_reg * alpha + ps;
#define PK4(P, BASE, OUT) do { unsigned a0 = cvtpk(P[BASE + 0], P[BASE + 1]), a1 = cvtpk(P[BASE + 2], P[BASE + 3]);   \
    unsigned b0 = cvtpk(P[BASE + 4], P[BASE + 5]), b1 = cvtpk(P[BASE + 6], P[BASE + 7]);                              \
    auto r0 = __builtin_amdgcn_permlane32_swap(a0, b0, false, false); auto r1 = __builtin_amdgcn_permlane32_swap(a1, b1, false, false); \
    u32x4 w = {r0[0], r1[0], r0[1], r1[1]}; OUT = *reinterpret_cast<bf16x8*>(&w); } while (0)
  PK4(p0, 0, pa0); PK4(p0, 8, pa1); PK4(p1, 0, pa2); PK4(p1, 8, pa3);
#undef PK4
}
__device__ __forceinline__ void qkt(f32x16& p0, f32x16& p1, const bf16* Ks, const bf16x8* qr, int r32, int hi) {
  p0 = f32x16{}; p1 = f32x16{};
  for (int d0 = 0; d0 < 8; ++d0) { int cb = (d0 * 16 + hi * 8) * 2;
    bf16x8 b0 = *reinterpret_cast<const bf16x8*>((const char*)Ks + KSWZ(r32, cb));
    bf16x8 b1 = *reinterpret_cast<const bf16x8*>((const char*)Ks + KSWZ(32 + r32, cb));
    p0 = __builtin_amdgcn_mfma_f32_32x32x16_bf16(b0, qr[d0], p0, 0, 0, 0);
    p1 = __builtin_amdgcn_mfma_f32_32x32x16_bf16(b1, qr[d0], p1, 0, 0, 0); }
}
__device__ __forceinline__ int v_st(int k, int c) { const int kk = (k & ~0xC) | ((k & 4) << 1) | ((k & 8) >> 1); return ((kk >> 3) * 4 + (c >> 5)) * 512 + ((kk & 7) * 32 + (c & 31)) * 2; }
__device__ __forceinline__ int v_rd_base(int lane) { return ((lane & 3) << 3) | (((lane >> 2) & 3) << 6) | (((lane >> 4) & 1) << 5) | (((lane >> 5) & 1) << 8); }
constexpr int v_rd_off(int d0, int ks, int half) { return d0 * 512 + ks * 4096 + half * 2048; }
template <int OFF> __device__ __forceinline__ s16x4 tr_read(int vb) {
  s16x4 r; asm volatile("ds_read_b64_tr_b16 %0, %1 offset:%2" : "=&v"(r) : "v"(vb), "i"(OFF) : "memory"); return r;
}
template <int D0> __device__ __forceinline__ void pv_one(f32x16& od, int vb, bf16x8 pa0, bf16x8 pa1, bf16x8 pa2, bf16x8 pa3) {
  const s16x4 l0 = tr_read<v_rd_off(D0, 0, 0)>(vb), h0 = tr_read<v_rd_off(D0, 0, 1)>(vb), l1 = tr_read<v_rd_off(D0, 1, 0)>(vb), h1 = tr_read<v_rd_off(D0, 1, 1)>(vb);
  const s16x4 l2 = tr_read<v_rd_off(D0, 2, 0)>(vb), h2 = tr_read<v_rd_off(D0, 2, 1)>(vb), l3 = tr_read<v_rd_off(D0, 3, 0)>(vb), h3 = tr_read<v_rd_off(D0, 3, 1)>(vb);
  asm volatile("s_waitcnt lgkmcnt(0)" ::: "memory"); SBAR();
#define PK(L, H) (bf16x8){L[0], L[1], L[2], L[3], H[0], H[1], H[2], H[3]}
  od = __builtin_amdgcn_mfma_f32_32x32x16_bf16(pa0, PK(l0, h0), od, 0, 0, 0);
  od = __builtin_amdgcn_mfma_f32_32x32x16_bf16(pa1, PK(l1, h1), od, 0, 0, 0);
  od = __builtin_amdgcn_mfma_f32_32x32x16_bf16(pa2, PK(l2, h2), od, 0, 0, 0);
  od = __builtin_amdgcn_mfma_f32_32x32x16_bf16(pa3, PK(l3, h3), od, 0, 0, 0);
#undef PK
}
__device__ __forceinline__ void pv_d0(f32x16* o, int vb, bf16x8 pa0, bf16x8 pa1, bf16x8 pa2, bf16x8 pa3) {
  pv_one<0>(o[0], vb, pa0, pa1, pa2, pa3); pv_one<1>(o[1], vb, pa0, pa1, pa2, pa3); pv_one<2>(o[2], vb, pa0, pa1, pa2, pa3); pv_one<3>(o[3], vb, pa0, pa1, pa2, pa3);
}

template <bool WIN>
__device__ __forceinline__ void attn_unit(const bf16* __restrict__ Qb, long ldq, const bf16* __restrict__ Kh, const bf16* __restrict__ Vh, long ldk,
                                          bf16* __restrict__ Ob, long ldo, int NT, char* lds, int e0, float slope2, float* __restrict__ lse_out, long ldl, const int tid) {
  const int wid = tid >> 6, lane = tid & 63, r32 = lane & 31, hi = lane >> 5;
  bf16* V_lds = (bf16*)lds; bf16* K_lds = (bf16*)(lds + 2 * SHM_V);
  float* ws = (float*)(lds + 2 * SHM_V + 2 * SHM_K) + wid * 64; float* li_l = ws; float* al_l = ws + 32;
  float m_reg = WIN ? -1e20f : -1e30f, l_reg = 0; f32x16 o[4] = {}; bf16x8 qr[8];
  const bf16* Qw = Qb + (long)(wid * QBLK + r32) * ldq + hi * 8;
#pragma unroll
  for (int d0 = 0; d0 < 8; ++d0) qr[d0] = *reinterpret_cast<const bf16x8*>(Qw + d0 * 16);
  const int sr = tid >> 4, sc = (tid & 15) * 8, vst0 = v_st(sr, sc), vst1 = v_st(32 + sr, sc);
  const int vb0 = (int)(uintptr_t)V_lds + v_rd_base(lane);
  float ef = (float)(e0 + 4 * hi - (wid * QBLK + r32));
  struct { bf16x8 vs0, vs1, ks0, ks1; } sr_[2];
  const unsigned voff0 = (unsigned)(sr * (int)ldk + sc) * 2u, voff1 = voff0 + (unsigned)(32 * (int)ldk) * 2u;
#define SLOAD(i, k0) do { const char* vt_ = (const char*)Vh + (size_t)(k0) * (size_t)ldk * 2; const char* kt_ = (const char*)Kh + (size_t)(k0) * (size_t)ldk * 2; \
    sr_[i].vs0 = *reinterpret_cast<const bf16x8*>(vt_ + voff0); sr_[i].vs1 = *reinterpret_cast<const bf16x8*>(vt_ + voff1); \
    sr_[i].ks0 = *reinterpret_cast<const bf16x8*>(kt_ + voff0); sr_[i].ks1 = *reinterpret_cast<const bf16x8*>(kt_ + voff1); } while (0)
#define SWRITE(b, i) do { *(bf16x8*)((char*)V_lds + (b) * SHM_V + vst0) = sr_[i].vs0;          \
    *(bf16x8*)((char*)V_lds + (b) * SHM_V + vst1) = sr_[i].vs1; int kc = sc * 2;               \
    *(bf16x8*)((char*)K_lds + (b) * SHM_K + KSWZ(sr, kc)) = sr_[i].ks0;                       \
    *(bf16x8*)((char*)K_lds + (b) * SHM_K + KSWZ(32 + sr, kc)) = sr_[i].ks1; } while (0)
#define SWAIT() do { asm volatile("s_waitcnt vmcnt(4)" ::: "memory"); } while (0)
#define RESC(a) do { if (__any((a) < 1.f)) { if (hi == 0) al_l[r32] = (a); asm volatile("s_waitcnt lgkmcnt(0)" ::: "memory"); \
    for (int d = 0; d < 4; ++d) for (int r = 0; r < 16; ++r) o[d][r] *= al_l[crow(r, hi)]; } } while (0)
#define PSM(P0, P1, MN, AL) do { if constexpr (WIN) { partialSM_win(P0, P1, m_reg, MN, AL, ef, slope2); ef += 64.f; } else partialSM(P0, P1, m_reg, MN, AL); } while (0)
  f32x16 pA0, pA1, pB0, pB1; float mnA, mnB, alA, alB; bf16x8 pa0, pa1, pa2, pa3;
  constexpr int SE = 0, SO = 1;
  SLOAD(SE, 0); asm volatile("s_waitcnt vmcnt(0)" ::: "memory"); SWRITE(0, SE); __syncthreads();
  qkt(pA0, pA1, K_lds, qr, r32, hi); PSM(pA0, pA1, mnA, alA);
  SLOAD(SO, KVBLK); if (2 < NT) SLOAD(SE, 2 * KVBLK);
  SWAIT(); SWRITE(1, SO); __syncthreads();
  for (int j = 1; j + 1 < NT; j += 2) {
    SBAR(); qkt(pB0, pB1, (bf16*)((char*)K_lds + SHM_K), qr, r32, hi);
    finishSM(pA0, pA1, alA, l_reg, pa0, pa1, pa2, pa3); SBAR();
    SLOAD(SO, (j + 2) * KVBLK); SBAR();
    pv_d0(o, vb0, pa0, pa1, pa2, pa3); PSM(pB0, pB1, mnB, alB);
    __syncthreads(); SWAIT(); SWRITE(0, SE);
    RESC(alB); __syncthreads();
    SBAR(); qkt(pA0, pA1, K_lds, qr, r32, hi);
    finishSM(pB0, pB1, alB, l_reg, pa0, pa1, pa2, pa3); SBAR();
    if (j + 3 < NT) SLOAD(SE, (j + 3) * KVBLK); SBAR();
    pv_d0(o, vb0 + (int)SHM_V, pa0, pa1, pa2, pa3); PSM(pA0, pA1, mnA, alA);
    __syncthreads(); SWAIT(); SWRITE(1, SO);
    RESC(alA); __syncthreads();
  }
  SBAR(); qkt(pB0, pB1, (bf16*)((char*)K_lds + SHM_K), qr, r32, hi);
  finishSM(pA0, pA1, alA, l_reg, pa0, pa1, pa2, pa3); SBAR();
  pv_d0(o, vb0, pa0, pa1, pa2, pa3); PSM(pB0, pB1, mnB, alB);
  __syncthreads(); RESC(alB);
  finishSM(pB0, pB1, alB, l_reg, pa0, pa1, pa2, pa3); SBAR();
  pv_d0(o, vb0 + (int)SHM_V, pa0, pa1, pa2, pa3);
  if (hi == 0) li_l[r32] = l_reg; asm volatile("s_waitcnt lgkmcnt(0)" ::: "memory");
  if constexpr (WIN) { if (hi == 0) lse_out[(long)(wid * QBLK + r32) * ldl] = (m_reg + __builtin_amdgcn_logf(l_reg)) * 0.6931471805599453f; }
  float rli[16];
#pragma unroll
  for (int r = 0; r < 16; ++r) rli[r] = __builtin_amdgcn_rcpf(li_l[crow(r, hi)]);
  bf16* Ow = Ob + (long)(wid * QBLK) * ldo;
#pragma unroll
  for (int r = 0; r < 16; ++r) { int orow = crow(r, hi);
    for (int d0 = 0; d0 < 4; ++d0) Ow[(long)orow * ldo + d0 * 32 + r32] = __float2bfloat16(o[d0][r] * rli[r]); }
#undef SLOAD
#undef SWRITE
#undef SWAIT
#undef RESC
#undef PSM
}
#undef KSWZ
#undef SBAR
}
#define LAS __attribute__((address_space(3)))
typedef unsigned short bf16u;
typedef unsigned v4u __attribute__((ext_vector_type(4)));
typedef unsigned v2u __attribute__((ext_vector_type(2)));
typedef float f32x4 __attribute__((ext_vector_type(4)));

constexpr int M = 16384, DM = 2048, SEQ = 4096, NIN = 10240, NQKV = 6144, NGATE = 4096, FF = 5632;
constexpr float ALPHA = 1.189207115002721f;
constexpr float RMS_EPS = 1e-6f, LN_EPS = 1e-5f;
constexpr int NTHR = 512, NWAVES = 8;
constexpr int LDS_BYTES = 131072 + 2048;

constexpr size_t MiB = 1u << 20;
constexpr size_t WS_WGU = 1 * MiB, WS_WDN = 45 * MiB, WS_WOUT = 67 * MiB, WS_WPA = 75 * MiB, WS_WPB = 79 * MiB;
constexpr size_t WS_WIN = 81 * MiB, WS_XB = 121 * MiB, WS_QKV = 185 * MiB, WS_G = 377 * MiB, WS_END = 505 * MiB;
constexpr size_t WS_OA = 81 * MiB, WS_OBP = 113 * MiB, WS_LSE = 161 * MiB, WS_OB = 162 * MiB;
constexpr size_t WS_MP = 185 * MiB, WS_X1B = 249 * MiB, WS_H = 313 * MiB;

struct Params {
    const float *x, *w_in, *b_gate, *qn, *kn, *wpa, *wpb, *wout, *ln1g, *ln1b, *wg, *wu, *wd, *ln2g, *ln2b;
    float* out; unsigned char* ws;
};

__device__ __forceinline__ unsigned f2bf(float f) { unsigned u = __builtin_bit_cast(unsigned, f); return (u + 0x7fffu + ((u >> 16) & 1u)) >> 16; }
__device__ __forceinline__ unsigned pk2(float lo, float hi) { return f2bf(lo) | (f2bf(hi) << 16); }
__device__ __forceinline__ float bf2f(unsigned short h) { return __uint_as_float((unsigned)h << 16); }
__device__ __forceinline__ float wave_sum(float v) {
#pragma unroll
    for (int o = 1; o < 64; o <<= 1) v += __shfl_xor(v, o);
    return v;
}

__device__ __forceinline__ void transpose_item(const float* W, int K, int N, bf16u* WT, int k0, int n0, int drow0, LAS float* scr, int lane) {
#pragma unroll 8
    for (int i = 0; i < 32; ++i) { const int kk = 2 * i + (lane >> 5); scr[kk * 33 + (lane & 31)] = W[(size_t)(k0 + kk) * N + n0 + (lane & 31)]; }
    asm volatile("s_waitcnt lgkmcnt(0)" ::: "memory");
    const int c = lane & 7;
#pragma unroll
    for (int j = 0; j < 4; ++j) { const int n = (lane >> 3) + 8 * j; const LAS float* s = scr + (8 * c) * 33 + n;
        v4u o; o.x = pk2(s[0 * 33], s[1 * 33]); o.y = pk2(s[2 * 33], s[3 * 33]); o.z = pk2(s[4 * 33], s[5 * 33]); o.w = pk2(s[6 * 33], s[7 * 33]);
        *(v4u*)(WT + (size_t)(drow0 + n) * K + k0 + 8 * c) = o; }
    asm volatile("s_waitcnt lgkmcnt(0)" ::: "memory");
}

__device__ __forceinline__ void ln_row(const float* src, const float* g, const float* b, float* dst, bf16u* dstb, int lane) {
    const f32x4* xr = (const f32x4*)src + lane;
    f32x4 v[8]; float s = 0.f;
#pragma unroll
    for (int j = 0; j < 8; ++j) { v[j] = xr[64 * j]; s += (v[j].x + v[j].y) + (v[j].z + v[j].w); }
    const float mean = wave_sum(s) * (1.f / DM); float s2 = 0.f;
#pragma unroll
    for (int j = 0; j < 8; ++j) { v[j] = v[j] - mean; s2 += (v[j].x * v[j].x + v[j].y * v[j].y) + (v[j].z * v[j].z + v[j].w * v[j].w); }
    const float rstd = 1.f / sqrtf(wave_sum(s2) * (1.f / DM) + LN_EPS);
    f32x4* o4 = (f32x4*)dst + lane;
#pragma unroll
    for (int j = 0; j < 8; ++j) { const f32x4 gg = ((const f32x4*)g)[64 * j + lane], bb = ((const f32x4*)b)[64 * j + lane];
        const f32x4 y = v[j] * rstd * gg + bb; o4[64 * j] = y;
        if (dstb) { v2u w; w.x = pk2(y.x, y.y); w.y = pk2(y.z, y.w); ((v2u*)dstb)[64 * j + lane] = w; } }
}

__global__ void __launch_bounds__(NTHR, 2) mega_fwd(Params p) {
    extern __shared__ __attribute__((aligned(16))) unsigned char lds[];
    cg::grid_group grid = cg::this_grid();
    const int wave = __builtin_amdgcn_readfirstlane((int)threadIdx.x >> 6);
#define FRESH_LANE(L) int L; asm volatile("v_mbcnt_lo_u32_b32 %0, -1, 0\n\tv_mbcnt_hi_u32_b32 %0, -1, %0" : "=v"(L))
    const int G = gridDim.x, bx = blockIdx.x;
    const int vcu = (G % 8 == 0) ? (bx % 8) * (G / 8) + bx / 8 : bx;
    const int gw = vcu * NWAVES + wave, NGW = G * NWAVES;
    unsigned char* ws = p.ws;
    bf16u* WGU = (bf16u*)(ws + WS_WGU); bf16u* WDN = (bf16u*)(ws + WS_WDN); bf16u* WOUT = (bf16u*)(ws + WS_WOUT);
    bf16u* WPA = (bf16u*)(ws + WS_WPA); bf16u* WPB = (bf16u*)(ws + WS_WPB); bf16u* WINT = (bf16u*)(ws + WS_WIN);
    bf16u* XB = (bf16u*)(ws + WS_XB); bf16u* QKV = (bf16u*)(ws + WS_QKV); bf16u* GB = (bf16u*)(ws + WS_G);
    bf16u* OA = (bf16u*)(ws + WS_OA); bf16u* OBP = (bf16u*)(ws + WS_OBP); float* LSE = (float*)(ws + WS_LSE); bf16u* OB = (bf16u*)(ws + WS_OB);
    bf16u* MP = (bf16u*)(ws + WS_MP); bf16u* X1B = (bf16u*)(ws + WS_X1B); bf16u* HB = (bf16u*)(ws + WS_H);
    LAS unsigned char* ldsl = (LAS unsigned char*)lds;

    {
        FRESH_LANE(lane); const int tid = wave * 64 + lane;
        LAS float* scr = (LAS float*)(ldsl + wave * 8704);
        constexpr int I_IN = 32 * 320, I_G = 32 * 176, I_U = I_G, I_D = 88 * 64, I_O = 32 * 64, I_PA = 16 * 64, I_PB = 8 * 64;
        constexpr int NITEMS = I_IN + I_G + I_U + I_D + I_O + I_PA + I_PB;
        for (int it = gw; it < NITEMS; it += NGW) {
            int r = it;
            if (r < I_IN) { const int kb = r / 320, nb = r % 320; transpose_item(p.w_in, 2048, NIN, WINT, 64 * kb, 32 * nb, 32 * nb, scr, lane); continue; } r -= I_IN;
            if (r < I_G) { const int kb = r / 176, nb = r % 176, n0 = 32 * nb; transpose_item(p.wg, 2048, FF, WGU, 64 * kb, n0, 256 * (n0 >> 7) + (n0 & 127), scr, lane); continue; } r -= I_G;
            if (r < I_U) { const int kb = r / 176, nb = r % 176, n0 = 32 * nb; transpose_item(p.wu, 2048, FF, WGU, 64 * kb, n0, 256 * (n0 >> 7) + 128 + (n0 & 127), scr, lane); continue; } r -= I_U;
            if (r < I_D) { const int kb = r / 64, nb = r % 64; transpose_item(p.wd, FF, 2048, WDN, 64 * kb, 32 * nb, 32 * nb, scr, lane); continue; } r -= I_D;
            if (r < I_O) { const int kb = r / 64, nb = r % 64; transpose_item(p.wout, 2048, 2048, WOUT, 64 * kb, 32 * nb, 32 * nb, scr, lane); continue; } r -= I_O;
            if (r < I_PA) { const int kb = r / 64, nb = r % 64; transpose_item(p.wpa, 1024, 2048, WPA, 64 * kb, 32 * nb, 32 * nb, scr, lane); continue; } r -= I_PA;
            { const int kb = r / 64, nb = r % 64; transpose_item(p.wpb, 512, 2048, WPB, 64 * kb, 32 * nb, 32 * nb, scr, lane); }
        }
        const size_t n8 = (size_t)M * DM / 8;
        for (size_t i = (size_t)bx * NTHR + tid; i < n8; i += (size_t)G * NTHR) {
            const f32x4 a = ((const f32x4*)p.x)[2 * i], b = ((const f32x4*)p.x)[2 * i + 1];
            v4u o; o.x = pk2(a.x, a.y); o.y = pk2(a.z, a.w); o.z = pk2(b.x, b.y); o.w = pk2(b.z, b.w);
            ((v4u*)XB)[i] = o;
        }
    }
    grid.sync();

    {
        pg8::Gemm g{XB, WINT, M, NIN, DM}; pg8::StaticOrder S; S.init(M, NIN, G, bx);
        pg8::EpiQKVG E{QKV, GB, p.b_gate};
        FRESH_LANE(lane); pg8::gemm_phase<pg8::EpiQKVG, pg8::StaticOrder, true, PG8_SP2>(ldsl, g, S, E, wave * 64 + lane);
    }
    grid.sync();

    {
        FRESH_LANE(lane);
        const int i = lane & 31, h2 = lane >> 5;
        const float freq = __builtin_amdgcn_exp2f(-(float)i * (13.287712379549449f / 32.f));
        const float gq0 = p.qn[i], gq1 = p.qn[i + 32], gq2 = p.qn[i + 64], gq3 = p.qn[i + 96];
        const float gk0 = p.kn[i], gk1 = p.kn[i + 32], gk2 = p.kn[i + 64], gk3 = p.kn[i + 96];
        for (int t = gw; t < M; t += NGW) {
            const int pos = t & (SEQ - 1), rid = pos >> 6, cid = pos & 63;
            float ar = (float)rid * freq * 0.15915494309189535f, ac = (float)cid * freq * 0.15915494309189535f;
            ar -= floorf(ar); ac -= floorf(ac);
            const float sr = __builtin_amdgcn_sinf(ar), cr = __builtin_amdgcn_cosf(ar), sc = __builtin_amdgcn_sinf(ac), cc = __builtin_amdgcn_cosf(ac);
#pragma unroll
            for (int it = 0; it < 5; ++it) {
                const int head = 2 * it + h2; bf16u* hp = QKV + (size_t)t * NQKV + head * 128;
                float a = bf2f(hp[i]), b = bf2f(hp[i + 32]), c = bf2f(hp[i + 64]), d = bf2f(hp[i + 96]);
                float ss = (a * a + b * b) + (c * c + d * d);
#pragma unroll
                for (int o = 1; o < 32; o <<= 1) ss += __shfl_xor(ss, o);
                const float rs = 1.f / sqrtf(ss * (1.f / 128.f) + RMS_EPS);
                const bool isq = head < 8;
                a *= rs * (isq ? gq0 : gk0); b *= rs * (isq ? gq1 : gk1); c *= rs * (isq ? gq2 : gk2); d *= rs * (isq ? gq3 : gk3);
                hp[i] = (bf16u)f2bf(a * cr - b * sr); hp[i + 32] = (bf16u)f2bf(b * cr + a * sr);
                hp[i + 64] = (bf16u)f2bf(c * cc - d * sc); hp[i + 96] = (bf16u)f2bf(d * cc + c * sc);
            }
        }
    }
    grid.sync();

    {
        FRESH_LANE(lane); const int tid = wave * 64 + lane;
        const att::bf16* Q = (const att::bf16*)QKV;
        for (int u = vcu; u < 512; u += G) {
            const int bk = u >> 6, b = bk >> 1, kvh = bk & 1, rem = u & 63, hq = kvh * 4 + (rem >> 4), qblk = rem & 15;
            const size_t row0 = (size_t)b * SEQ;
            att::attn_unit<false>(Q + (row0 + qblk * 256) * NQKV + hq * 128, NQKV, Q + row0 * NQKV + 1024 + kvh * 128, Q + row0 * NQKV + 1280 + kvh * 128, NQKV,
                                  (att::bf16*)OA + (row0 + qblk * 256) * 1024 + hq * 128, 1024, SEQ / 64, (char*)lds, 0, 0.f, nullptr, 0, tid);
        }
        FRESH_LANE(laneb); const int tidb = wave * 64 + laneb;
        for (int u = vcu; u < 768; u += G) {
            const int g = u >> 8, idx = u & 255, b = idx >> 6, h = (idx >> 4) & 3, sub = idx & 15;
            const int dil = g == 0 ? 1 : (g == 1 ? 4 : 16), lsub = SEQ / dil;
            const int c = g == 0 ? 0 : (g == 1 ? (sub >> 2) : sub), qblk = g == 0 ? sub : (g == 1 ? (sub & 3) : 0);
            const int q0 = qblk * 256, NT = g == 2 ? 4 : 6;
            int kv0 = q0 - 64; if (kv0 > lsub - 64 * NT) kv0 = lsub - 64 * NT; if (kv0 < 0) kv0 = 0;
            const int gh = g * 4 + h;
            const float slope2 = __builtin_amdgcn_exp2f(-8.f * (float)(gh + 1) / 12.f) * (float)dil * 1.4426950408889634f;
            const size_t row0 = (size_t)b * SEQ + c;
            att::attn_unit<true>(Q + (row0 + (size_t)dil * q0) * NQKV + 1536 + gh * 128, (long)dil * NQKV,
                                 Q + (row0 + (size_t)dil * kv0) * NQKV + 3072 + gh * 128, Q + (row0 + (size_t)dil * kv0) * NQKV + 4608 + gh * 128, (long)dil * NQKV,
                                 (att::bf16*)OBP + (size_t)g * M * 512 + (row0 + (size_t)dil * q0) * 512 + h * 128, (long)dil * 512, NT, (char*)lds, kv0 - q0, slope2,
                                 LSE + (size_t)g * M * 4 + (row0 + (size_t)dil * q0) * 4 + h, (long)dil * 4, tidb);
        }
    }
    grid.sync();

    {
        FRESH_LANE(lane);
        for (int t = gw; t < M; t += NGW) {
            const int h = lane >> 4;
            const float l0 = LSE[(size_t)t * 4 + h], l1 = LSE[(size_t)M * 4 + (size_t)t * 4 + h], l2 = LSE[(size_t)2 * M * 4 + (size_t)t * 4 + h];
            const float mx = fmaxf(l0, fmaxf(l1, l2));
            float w0 = __expf(l0 - mx), w1 = __expf(l1 - mx), w2 = __expf(l2 - mx); const float inv = 1.f / (w0 + w1 + w2); w0 *= inv; w1 *= inv; w2 *= inv;
            const v4u a = ((const v4u*)(OBP + (size_t)t * 512))[lane], b = ((const v4u*)(OBP + (size_t)M * 512 + (size_t)t * 512))[lane], c = ((const v4u*)(OBP + (size_t)2 * M * 512 + (size_t)t * 512))[lane];
            v4u o;
#pragma unroll
            for (int e = 0; e < 4; ++e) {
                const float lo = w0 * __uint_as_float(a[e] << 16) + w1 * __uint_as_float(b[e] << 16) + w2 * __uint_as_float(c[e] << 16);
                const float hi = w0 * __uint_as_float(a[e] & 0xffff0000u) + w1 * __uint_as_float(b[e] & 0xffff0000u) + w2 * __uint_as_float(c[e] & 0xffff0000u);
                o[e] = pk2(lo, hi); }
            ((v4u*)(OB + (size_t)t * 512))[lane] = o;
        }
        pg8::Gemm g{OA, WPA, M, DM, 1024}; pg8::StaticOrder S; S.init(M, DM, G, bx);
        pg8::EpiGateA E{p.out, GB};
        FRESH_LANE(lane2); pg8::gemm_phase<pg8::EpiGateA, pg8::StaticOrder, true, PG8_SP2>(ldsl, g, S, E, wave * 64 + lane2);
    }
    grid.sync();

    {
        pg8::Gemm g{OB, WPB, M, DM, 512}; pg8::StaticOrder S; S.init(M, DM, G, bx);
        pg8::EpiGateB E{p.out, GB, MP};
        FRESH_LANE(lane2); pg8::gemm_phase<pg8::EpiGateB, pg8::StaticOrder, true, PG8_SP2>(ldsl, g, S, E, wave * 64 + lane2);
    }
    grid.sync();

    {
        pg8::Gemm g{MP, WOUT, M, DM, DM}; pg8::StaticOrder S; S.init(M, DM, G, bx);
        pg8::EpiResid E{p.x, p.out, ALPHA};
        FRESH_LANE(lane2); pg8::gemm_phase<pg8::EpiResid, pg8::StaticOrder, true, PG8_SP2>(ldsl, g, S, E, wave * 64 + lane2);
    }
    grid.sync();

    { FRESH_LANE(lane); for (int t = gw; t < M; t += NGW) ln_row(p.out + (size_t)t * DM, p.ln1g, p.ln1b, p.out + (size_t)t * DM, X1B + (size_t)t * DM, lane); }
    grid.sync();

    {
        pg8::Gemm g{X1B, WGU, M, 2 * FF, DM}; pg8::StaticOrder S; S.init(M, 2 * FF, G, bx);
        pg8::EpiSwiGLU E{HB};
        FRESH_LANE(lane2); pg8::gemm_phase<pg8::EpiSwiGLU, pg8::StaticOrder, true, PG8_SP2>(ldsl, g, S, E, wave * 64 + lane2);
    }
    grid.sync();

    {
        pg8::Gemm g{HB, WDN, M, DM, FF}; pg8::StaticOrder S; S.init(M, DM, G, bx);
        pg8::EpiResid E{p.out, p.out, ALPHA};
        FRESH_LANE(lane2); pg8::gemm_phase<pg8::EpiResid, pg8::StaticOrder, true, PG8_SP2>(ldsl, g, S, E, wave * 64 + lane2);
    }
    grid.sync();

    { FRESH_LANE(lane); for (int t = gw; t < M; t += NGW) ln_row(p.out + (size_t)t * DM, p.ln2g, p.ln2b, p.out + (size_t)t * DM, nullptr, lane); }
}

extern "C" void kernel_launch(void* const* d_in, const int* in_sizes, int n_in, void* d_out, int out_size, void* d_ws, size_t ws_size, hipStream_t stream) {
    static int grid = 0;
    if (grid == 0) {
        if (n_in != 15 || in_sizes[0] != M * DM || out_size != M * DM || ws_size < WS_END) {
            fprintf(stderr, "kernel_launch: shape mismatch n_in %d in0 %d out %d ws %zu (need %zu)\n", n_in, n_in > 0 ? in_sizes[0] : -1, out_size, ws_size, (size_t)WS_END); grid = -1; return; }
        int dev = 0, cus = 0, per_cu = 0;
        hipGetDevice(&dev); hipDeviceGetAttribute(&cus, hipDeviceAttributeMultiprocessorCount, dev);
        if (hipFuncSetAttribute((const void*)mega_fwd, hipFuncAttributeMaxDynamicSharedMemorySize, LDS_BYTES) != hipSuccess) { fprintf(stderr, "kernel_launch: hipFuncSetAttribute failed\n"); grid = -1; return; }
        if (hipOccupancyMaxActiveBlocksPerMultiprocessor(&per_cu, (const void*)mega_fwd, NTHR, LDS_BYTES) != hipSuccess || per_cu < 1) { fprintf(stderr, "kernel_launch: occupancy query gave %d\n", per_cu); per_cu = 1; }
        (void)hipGetLastError();
        grid = cus * per_cu;
    }
    if (grid < 0) return;
    Params p{};
    p.x = (const float*)d_in[0]; p.w_in = (const float*)d_in[1]; p.b_gate = (const float*)d_in[2]; p.qn = (const float*)d_in[3]; p.kn = (const float*)d_in[4];
    p.wpa = (const float*)d_in[5]; p.wpb = (const float*)d_in[6]; p.wout = (const float*)d_in[7]; p.ln1g = (const float*)d_in[8]; p.ln1b = (const float*)d_in[9];
    p.wg = (const float*)d_in[10]; p.wu = (const float*)d_in[11]; p.wd = (const float*)d_in[12]; p.ln2g = (const float*)d_in[13]; p.ln2b = (const float*)d_in[14];
    p.out = (float*)d_out; p.ws = (unsigned char*)d_ws;
    void* args[] = {&p};
    hipError_t e = hipLaunchCooperativeKernel((const void*)mega_fwd, dim3(grid), dim3(NTHR), args, LDS_BYTES, stream);
    if (e != hipSuccess) fprintf(stderr, "kernel_launch: cooperative launch failed: %s (grid %d)\n", hipGetErrorString(e), grid);
}
```

```cpp
#include <hip/hip_runtime.h>
#include <hip/hip_bf16.h>
#include <hip/hip_cooperative_groups.h>
#include <cstdio>
#include <cstdint>
#include <cmath>
namespace cg = cooperative_groups;
namespace pg8 {
#define PG8_LAS __attribute__((address_space(3)))
typedef unsigned short bf16_t;
typedef short bf16x8 __attribute__((ext_vector_type(8)));
typedef float f32x4 __attribute__((ext_vector_type(4)));
typedef unsigned u32x4 __attribute__((ext_vector_type(4)));
constexpr int BM = 256, BK = 64, HALF = 128, HTB = HALF * BK * 2  , STAGE_BYTES = 8 * HTB, NXCD = 8, WGM = 8;

__host__ __device__ __forceinline__ int lds_byte(int r, int c) { const int st = (r >> 4) * 2 + (c >> 5), rr = r & 15, cc = c & 31, ob = rr * 64 + cc * 2; return st * 1024 + (ob ^ (((ob >> 9) & 1) << 5)); }
__host__ __device__ __forceinline__ void stage_rc(int b, int& R, int& C) { const int st = b / 1024, sb = b % 1024, swz = sb ^ (((sb >> 9) & 1) << 5); R = (st >> 1) * 16 + swz / 64; C = (st & 1) * 32 + (swz % 64) / 2; }
__host__ __device__ __forceinline__ int perm32(int rho) { const int n = rho >> 4, i = rho & 15; return 8 * (i >> 2) + 4 * n + (i & 3); }

struct Unit { int pm, pn; };
struct Gemm { const bf16_t* A; const bf16_t* Bt; int M, N, K; };

struct StaticOrder {
    int nM, nN, nwg, G, c;
    __host__ __device__ void init(int M, int N, int G_, int c_) { nM = M / BM; nN = N / BM; nwg = nM * nN; G = G_; c = c_; }
    __host__ __device__ bool next(int i, Unit& u) const {
        const long L = (long)i * G + c; if (L >= nwg) return false;
        int wgid = (int)L; { const int q = nwg / NXCD, r = nwg % NXCD, xcd = wgid % NXCD, off = wgid / NXCD; wgid = (xcd < r ? xcd * (q + 1) : r * (q + 1) + (xcd - r) * q) + off; }
        const int nig = WGM * nN, gid = wgid / nig, fm = gid * WGM, gsz = (nM - fm) < WGM ? (nM - fm) : WGM;
        u.pm = fm + ((wgid % nig) % gsz); u.pn = (wgid % nig) / gsz; return true;
    }
    __device__ __forceinline__ void a_ready(const Unit&) const {}
    __device__ __forceinline__ void done(const Unit&) const {}
};

typedef float f32x2_t __attribute__((ext_vector_type(2))); typedef __bf16 bf16x2_t __attribute__((ext_vector_type(2)));
__device__ __forceinline__ unsigned cvt_pk_bf16(float lo, float hi) { f32x2_t v = {lo, hi}; bf16x2_t b = __builtin_convertvector(v, bf16x2_t); return __builtin_bit_cast(unsigned, b); }
typedef float f32x2 __attribute__((ext_vector_type(2)));
typedef unsigned u32x2 __attribute__((ext_vector_type(2)));
__device__ __forceinline__ float sigmoid_f(float x) { return __builtin_amdgcn_rcpf(1.0f + __builtin_amdgcn_exp2f(-1.4426950408889634f * x)); }
__device__ __forceinline__ float bf_lo(unsigned w) { return __uint_as_float(w << 16); }
__device__ __forceinline__ float bf_hi(unsigned w) { return __uint_as_float(w & 0xffff0000u); }

struct EpiQKVG {
    static constexpr bool PERM = true, AFTER_DRAIN = false;
    bf16_t* QKV; bf16_t* G; const float* bgate;
    __device__ __forceinline__ void operator()(const f32x4 (&acc)[2][2][4][2], const Unit& u, int wr, int wc, int fr, int fq) const {
        const int row0 = u.pm * BM + wr * 64 + fr;
        if (u.pn < 24) {
            const int col0 = u.pn * BM + wc * 32 + 8 * fq;
#pragma unroll
            for (int ai = 0; ai < 2; ++ai)
#pragma unroll
                for (int m = 0; m < 4; ++m) { bf16_t* rowp = QKV + (size_t)(row0 + ai * HALF + m * 16) * 6144 + col0;
#pragma unroll
                    for (int bj = 0; bj < 2; ++bj) { const f32x4 v0 = acc[ai][bj][m][0], v1 = acc[ai][bj][m][1];
                        u32x4 w; w.x = cvt_pk_bf16(v0[0], v0[1]); w.y = cvt_pk_bf16(v0[2], v0[3]); w.z = cvt_pk_bf16(v1[0], v1[1]); w.w = cvt_pk_bf16(v1[2], v1[3]);
                        *(u32x4*)(rowp + bj * HALF) = w; } }
        } else {
            const int col0 = (u.pn - 24) * BM + wc * 32 + 8 * fq;
            f32x4 bv[2][2];
#pragma unroll
            for (int bj = 0; bj < 2; ++bj)
#pragma unroll
                for (int n = 0; n < 2; ++n) bv[bj][n] = *(const f32x4*)(bgate + col0 + bj * HALF + 4 * n);
#pragma unroll
            for (int ai = 0; ai < 2; ++ai)
#pragma unroll
                for (int m = 0; m < 4; ++m) { bf16_t* rowp = G + (size_t)(row0 + ai * HALF + m * 16) * 4096 + col0;
#pragma unroll
                    for (int bj = 0; bj < 2; ++bj) { f32x4 v0 = acc[ai][bj][m][0] + bv[bj][0], v1 = acc[ai][bj][m][1] + bv[bj][1];
#pragma unroll
                        for (int e = 0; e < 4; ++e) { v0[e] = sigmoid_f(v0[e]); v1[e] = sigmoid_f(v1[e]); }
                        u32x4 w; w.x = cvt_pk_bf16(v0[0], v0[1]); w.y = cvt_pk_bf16(v0[2], v0[3]); w.z = cvt_pk_bf16(v1[0], v1[1]); w.w = cvt_pk_bf16(v1[2], v1[3]);
                        *(u32x4*)(rowp + bj * HALF) = w; } }
        }
    }
};

struct EpiGateA {
    static constexpr bool PERM = false, AFTER_DRAIN = false;
    float* T; const bf16_t* G;
    __device__ __forceinline__ void operator()(const f32x4 (&acc)[2][2][4][2], const Unit& u, int wr, int wc, int fr, int fq) const {
        const int row0 = u.pm * BM + wr * 64 + fr, col0 = u.pn * BM + wc * 32 + 4 * fq;
#pragma unroll
        for (int ai = 0; ai < 2; ++ai)
#pragma unroll
            for (int m = 0; m < 4; ++m) { const size_t r = (size_t)(row0 + ai * HALF + m * 16);
#pragma unroll
                for (int bj = 0; bj < 2; ++bj)
#pragma unroll
                    for (int n = 0; n < 2; ++n) { const int c = col0 + bj * HALF + n * 16;
                        const u32x2 g = *(const u32x2*)(G + r * 4096 + c); const f32x4 a = acc[ai][bj][m][n];
                        f32x4 o; o[0] = a[0] * bf_lo(g.x); o[1] = a[1] * bf_hi(g.x); o[2] = a[2] * bf_lo(g.y); o[3] = a[3] * bf_hi(g.y);
                        *(f32x4*)(T + r * 2048 + c) = o; }
                if (m & 1) asm volatile("" ::: "memory"); }
    }
};

struct EpiGateB {
    static constexpr bool PERM = true, AFTER_DRAIN = false;
    const float* T; const bf16_t* G; bf16_t* MP;
    __device__ __forceinline__ void operator()(const f32x4 (&acc)[2][2][4][2], const Unit& u, int wr, int wc, int fr, int fq) const {
        const int row0 = u.pm * BM + wr * 64 + fr, col0 = u.pn * BM + wc * 32 + 8 * fq;
#pragma unroll
        for (int ai = 0; ai < 2; ++ai)
#pragma unroll
            for (int m = 0; m < 4; ++m) { const size_t r = (size_t)(row0 + ai * HALF + m * 16);
#pragma unroll
                for (int bj = 0; bj < 2; ++bj) { const int c = col0 + bj * HALF;
                    const u32x4 g = *(const u32x4*)(G + r * 4096 + 2048 + c);
                    const f32x4 t0 = *(const f32x4*)(T + r * 2048 + c), t1 = *(const f32x4*)(T + r * 2048 + c + 4);
                    const f32x4 a0 = acc[ai][bj][m][0], a1 = acc[ai][bj][m][1];
                    u32x4 w;
                    w.x = cvt_pk_bf16(t0[0] + a0[0] * bf_lo(g.x), t0[1] + a0[1] * bf_hi(g.x));
                    w.y = cvt_pk_bf16(t0[2] + a0[2] * bf_lo(g.y), t0[3] + a0[3] * bf_hi(g.y));
                    w.z = cvt_pk_bf16(t1[0] + a1[0] * bf_lo(g.z), t1[1] + a1[1] * bf_hi(g.z));
                    w.w = cvt_pk_bf16(t1[2] + a1[2] * bf_lo(g.w), t1[3] + a1[3] * bf_hi(g.w));
                    *(u32x4*)(MP + r * 2048 + c) = w; }
                if (m & 1) asm volatile("" ::: "memory"); }
    }
};

struct EpiResid {
    static constexpr bool PERM = false, AFTER_DRAIN = false;
    const float* base; float* out; float alpha;
    __device__ __forceinline__ void operator()(const f32x4 (&acc)[2][2][4][2], const Unit& u, int wr, int wc, int fr, int fq) const {
        const int row0 = u.pm * BM + wr * 64 + fr, col0 = u.pn * BM + wc * 32 + 4 * fq;
#pragma unroll
        for (int ai = 0; ai < 2; ++ai)
#pragma unroll
            for (int m = 0; m < 4; ++m) { const size_t r = (size_t)(row0 + ai * HALF + m * 16);
#pragma unroll
                for (int bj = 0; bj < 2; ++bj)
#pragma unroll
                    for (int n = 0; n < 2; ++n) { const int c = col0 + bj * HALF + n * 16;
                        const f32x4 b = *(const f32x4*)(base + r * 2048 + c);
                        *(f32x4*)(out + r * 2048 + c) = b * alpha + acc[ai][bj][m][n]; }
                if (m & 1) asm volatile("" ::: "memory"); }
    }
};

struct EpiSwiGLU {
    static constexpr bool PERM = true, AFTER_DRAIN = false;
    bf16_t* H;
    __device__ __forceinline__ void operator()(const f32x4 (&acc)[2][2][4][2], const Unit& u, int wr, int wc, int fr, int fq) const {
        const int row0 = u.pm * BM + wr * 64 + fr, col0 = u.pn * HALF + wc * 32 + 8 * fq;
#pragma unroll
        for (int ai = 0; ai < 2; ++ai)
#pragma unroll
            for (int m = 0; m < 4; ++m) { bf16_t* rowp = H + (size_t)(row0 + ai * HALF + m * 16) * 5632 + col0;
                f32x4 h0, h1;
#pragma unroll
                for (int e = 0; e < 4; ++e) { const float g0 = acc[ai][0][m][0][e], g1 = acc[ai][0][m][1][e];
                    h0[e] = g0 * sigmoid_f(g0) * acc[ai][1][m][0][e]; h1[e] = g1 * sigmoid_f(g1) * acc[ai][1][m][1][e]; }
                u32x4 w; w.x = cvt_pk_bf16(h0[0], h0[1]); w.y = cvt_pk_bf16(h0[2], h0[3]); w.z = cvt_pk_bf16(h1[0], h1[1]); w.w = cvt_pk_bf16(h1[2], h1[3]);
                *(u32x4*)rowp = w; }
    }
};

template <class Epi, class Sched, bool ALIGN_EPI = false, bool SP2 = false>
__device__ __forceinline__ void gemm_phase(PG8_LAS unsigned char* lds, const Gemm g, const Sched& S, const Epi& E, const int tid  ) {
    const int wid = __builtin_amdgcn_readfirstlane(tid >> 6), lane = tid & 63, wr = wid >> 2, wc = wid & 3, fr = lane & 15, fq = lane >> 4;
    const int K = g.K, nt = K / BK;
    unsigned voffA[2], voffB[2];
#pragma unroll
    for (int i = 0; i < 2; ++i) { int R, C; stage_rc(tid * 16 + i * 8192, R, C); const int Rb = Epi::PERM ? ((R & ~31) + perm32(R & 31)) : R;
        voffA[i] = (unsigned)(R * K + C) * 2u; voffB[i] = (unsigned)(Rb * K + C) * 2u; }
    const size_t kstep = (size_t)(BK * 2);
    const size_t hstep = (size_t)HALF * K * 2;
    const size_t tstep = 2 * hstep;
    const unsigned ldsw = (unsigned)wid * 1024u;
    const int aoff = lds_byte(wr * 64 + fr, fq * 8), boff = lds_byte(wc * 32 + fr, fq * 8);
#define PG8_SA(b, h) (((b) * 2 + (h)) * HTB)
#define PG8_SB(b, h) ((4 + (b) * 2 + (h)) * HTB)
#define PG8_STAGE(bufoff, gbase, voff) do { _Pragma("unroll") for (int _i = 0; _i < 2; ++_i) \
        __builtin_amdgcn_global_load_lds((const unsigned*)((const char*)(gbase) + (voff)[_i]), (PG8_LAS unsigned*)(lds + (bufoff) + ldsw + _i * 8192), 16, 0, 0); } while (0)
#define PG8_LDA(dst, b, h) do { _Pragma("unroll") for (int m = 0; m < 4; ++m) _Pragma("unroll") for (int k = 0; k < 2; ++k) dst[m][k] = *(const PG8_LAS bf16x8*)(lds + PG8_SA(b, h) + aoff + m * 2048 + k * 1024); } while (0)
#define PG8_LDB(dst, b, h) do { _Pragma("unroll") for (int n = 0; n < 2; ++n) _Pragma("unroll") for (int k = 0; k < 2; ++k) dst[n][k] = *(const PG8_LAS bf16x8*)(lds + PG8_SB(b, h) + boff + n * 2048 + k * 1024); } while (0)
#define PG8_MMA(ai, bj, At, Bt) do { __builtin_amdgcn_s_setprio(1); _Pragma("unroll") for (int m = 0; m < 4; ++m) _Pragma("unroll") for (int n = 0; n < 2; ++n) _Pragma("unroll") for (int k = 0; k < 2; ++k) \
        acc[ai][bj][m][n] = __builtin_amdgcn_mfma_f32_16x16x32_bf16(Bt[n][k], At[m][k], acc[ai][bj][m][n], 0, 0, 0); __builtin_amdgcn_s_setprio(0); } while (0)
#define PG8_WAIT_V(n) asm volatile("s_waitcnt vmcnt(" #n ")" ::: "memory")
#define PG8_WAIT_L(n) asm volatile("s_waitcnt lgkmcnt(" #n ")" ::: "memory")
#define PG8_BAR __builtin_amdgcn_s_barrier()
#define PG8_SCHED __builtin_amdgcn_sched_barrier(0)
    Unit cur, nxt; int ui = 0;
    if (!S.next(0, cur)) return;
    f32x4 acc[2][2][4][2];
#pragma unroll
    for (int a = 0; a < 2; ++a)
#pragma unroll
        for (int b = 0; b < 2; ++b)
#pragma unroll
            for (int m = 0; m < 4; ++m)
#pragma unroll
                for (int n = 0; n < 2; ++n) acc[a][b][m][n] = (f32x4){0.f, 0.f, 0.f, 0.f};
    bf16x8 At[4][2], B0[2][2], B1[2][2];
    const char* cA = (const char*)g.A + (size_t)cur.pm * tstep; const char* cB = (const char*)g.Bt + (size_t)cur.pn * tstep;
    S.a_ready(cur);
    if constexpr (SP2) {
        PG8_STAGE(PG8_SB(0, 0), cB, voffB); PG8_STAGE(PG8_SB(0, 1), cB + hstep, voffB); PG8_STAGE(PG8_SA(0, 0), cA, voffA); PG8_STAGE(PG8_SA(0, 1), cA + hstep, voffA);
        if (wr == 1) PG8_BAR;
        PG8_WAIT_V(2); PG8_BAR;
        PG8_STAGE(PG8_SB(1, 0), cB + kstep, voffB); PG8_STAGE(PG8_SA(1, 0), cA + kstep, voffA); PG8_STAGE(PG8_SB(1, 1), cB + hstep + kstep, voffB);
        PG8_WAIT_V(6); PG8_BAR;
    } else {
        PG8_STAGE(PG8_SB(0, 0), cB, voffB); PG8_STAGE(PG8_SA(0, 0), cA, voffA); PG8_STAGE(PG8_SB(0, 1), cB + hstep, voffB); PG8_STAGE(PG8_SA(0, 1), cA + hstep, voffA);
        if (wr == 1) PG8_BAR;
        PG8_WAIT_V(4); PG8_BAR;
        PG8_STAGE(PG8_SB(1, 0), cB + kstep, voffB); PG8_STAGE(PG8_SA(1, 0), cA + kstep, voffA); PG8_STAGE(PG8_SB(1, 1), cB + hstep + kstep, voffB);
        PG8_WAIT_V(6); PG8_BAR;
    }
    for (;;) {
        const bool has_next = S.next(ui + 1, nxt);
        const char* nA = has_next ? (const char*)g.A + (size_t)nxt.pm * tstep : cA; const char* nB = has_next ? (const char*)g.Bt + (size_t)nxt.pn * tstep : cB;
        for (int t = 0; t < nt; t += 2) {
            const bool last = (t == nt - 2);
            const char* a1 = cA + (size_t)(t + 1) * kstep;
            const char* a2 = last ? nA : cA + (size_t)(t + 2) * kstep; const char* b2 = last ? nB : cB + (size_t)(t + 2) * kstep;
            const char* a3 = a2 + kstep; const char* b3 = b2 + kstep;
            if (last && has_next) S.a_ready(nxt);
            if constexpr (SP2) {
            PG8_LDB(B0, 0, 0); PG8_LDB(B1, 0, 1); PG8_SCHED; PG8_LDA(At, 0, 0); PG8_STAGE(PG8_SA(1, 1), a1 + hstep, voffA);
            PG8_WAIT_V(8); PG8_WAIT_L(0); PG8_BAR; PG8_MMA(0, 0, At, B0); PG8_MMA(0, 1, At, B1); PG8_BAR; PG8_SCHED;
            PG8_LDA(At, 0, 1); PG8_STAGE(PG8_SB(0, 0), b2, voffB); PG8_STAGE(PG8_SB(0, 1), b2 + hstep, voffB); PG8_STAGE(PG8_SA(0, 0), a2, voffA);
            PG8_WAIT_V(8); PG8_WAIT_L(0); PG8_BAR; PG8_MMA(1, 0, At, B0); PG8_MMA(1, 1, At, B1); PG8_BAR; PG8_SCHED;
            PG8_LDB(B0, 1, 0); PG8_LDB(B1, 1, 1); PG8_SCHED; PG8_LDA(At, 1, 0); PG8_STAGE(PG8_SA(0, 1), a2 + hstep, voffA);
            PG8_WAIT_V(8); PG8_WAIT_L(0); PG8_BAR; PG8_MMA(0, 0, At, B0); PG8_MMA(0, 1, At, B1); PG8_BAR; PG8_SCHED;
            PG8_LDA(At, 1, 1); PG8_STAGE(PG8_SB(1, 0), b3, voffB); PG8_STAGE(PG8_SB(1, 1), b3 + hstep, voffB); PG8_STAGE(PG8_SA(1, 0), a3, voffA);
            PG8_WAIT_V(8); PG8_WAIT_L(0); PG8_BAR; PG8_MMA(1, 0, At, B0); PG8_MMA(1, 1, At, B1); PG8_BAR; PG8_SCHED;
            } else {
            PG8_LDB(B0, 0, 0); PG8_SCHED; PG8_LDA(At, 0, 0); PG8_STAGE(PG8_SA(1, 1), a1 + hstep, voffA);
            PG8_WAIT_L(8); PG8_BAR; PG8_WAIT_L(0); PG8_MMA(0, 0, At, B0); PG8_BAR; PG8_SCHED;
            PG8_LDB(B1, 0, 1); PG8_STAGE(PG8_SB(0, 0), b2, voffB);
            PG8_BAR; PG8_WAIT_L(0); PG8_MMA(0, 1, At, B1); PG8_BAR;
            PG8_LDA(At, 0, 1); PG8_STAGE(PG8_SA(0, 0), a2, voffA);
            PG8_BAR; PG8_WAIT_L(0); PG8_MMA(1, 0, At, B0); PG8_BAR; PG8_SCHED;
            PG8_STAGE(PG8_SB(0, 1), b2 + hstep, voffB);
            PG8_WAIT_V(6); PG8_BAR; PG8_MMA(1, 1, At, B1); PG8_BAR;
            PG8_LDB(B0, 1, 0); PG8_SCHED; PG8_LDA(At, 1, 0); PG8_STAGE(PG8_SA(0, 1), a2 + hstep, voffA);
            PG8_WAIT_L(8); PG8_BAR; PG8_WAIT_L(0); PG8_MMA(0, 0, At, B0); PG8_BAR; PG8_SCHED;
            PG8_LDB(B1, 1, 1); PG8_STAGE(PG8_SB(1, 0), b3, voffB);
            PG8_BAR; PG8_WAIT_L(0); PG8_MMA(0, 1, At, B1); PG8_BAR;
            PG8_LDA(At, 1, 1); PG8_STAGE(PG8_SA(1, 0), a3, voffA);
            PG8_BAR; PG8_WAIT_L(0); PG8_MMA(1, 0, At, B0); PG8_BAR; PG8_SCHED;
            PG8_STAGE(PG8_SB(1, 1), b3 + hstep, voffB);
            PG8_WAIT_V(6); PG8_BAR; PG8_MMA(1, 1, At, B1); PG8_BAR;
            }
        }
        if constexpr (ALIGN_EPI) { if (wr == 0) PG8_BAR; }
        if constexpr (!Epi::AFTER_DRAIN) { E(acc, cur, wr, wc, fr, fq); S.done(cur); }
        if (!has_next) break;
#pragma unroll
        for (int a = 0; a < 2; ++a)
#pragma unroll
            for (int b = 0; b < 2; ++b)
#pragma unroll
                for (int m = 0; m < 4; ++m)
#pragma unroll
                    for (int n = 0; n < 2; ++n) acc[a][b][m][n] = (f32x4){0.f, 0.f, 0.f, 0.f};
        cur = nxt; cA = nA; cB = nB; ++ui;
        if constexpr (ALIGN_EPI) { if (wr == 1) PG8_BAR; }
    }
    PG8_WAIT_V(0);
    if constexpr (!ALIGN_EPI) { if (wr == 0) PG8_BAR; }
    PG8_BAR;
    if constexpr (Epi::AFTER_DRAIN) { E.fused(acc, cur, wr, wc, fr, fq, lds, wid, lane); S.done(cur); }
#undef PG8_SA
#undef PG8_SB
#undef PG8_STAGE
#undef PG8_LDA
#undef PG8_LDB
#undef PG8_MMA
#undef PG8_WAIT_V
#undef PG8_WAIT_L
#undef PG8_BAR
#undef PG8_SCHED
}
}

#ifndef PG8_SP2
#define PG8_SP2 true
#endif
namespace att {
using bf16 = __hip_bfloat16;
constexpr int D = 128, NW = 8, QBLK = 32, KVBLK = 64;
constexpr float SCALE = 0.088388347648318440f;
constexpr float THR = 8.f;
constexpr float LOG2E = 1.4426950408889634f;
constexpr size_t SHM_V = KVBLK * D * 2, SHM_K = KVBLK * D * 2, SHM_ATTN = 2 * SHM_V + 2 * SHM_K + NW * 64 * 4;
using bf16x8 = __attribute__((ext_vector_type(8))) short;
using s16x4  = __attribute__((ext_vector_type(4))) short;
using f32x16 = __attribute__((ext_vector_type(16))) float;
using u32x4  = __attribute__((ext_vector_type(4))) unsigned;
#define KSWZ(row, colB) ((row) * 256 + ((colB) ^ (((row) & 7) << 4)))
#define SBAR() __builtin_amdgcn_sched_barrier(0)
__device__ __forceinline__ int crow(int r, int hi) { return (r & 3) + 8 * (r >> 2) + 4 * hi; }
__device__ __forceinline__ unsigned cvtpk(float lo, float hi) { return pg8::cvt_pk_bf16(lo, hi); }
__device__ __forceinline__ void partialSM(f32x16& p0, f32x16& p1, float& m_reg, float& mn, float& alpha) {
  constexpr float C = SCALE * LOG2E;
  float pmax = p0[0]; for (int r = 1; r < 16; ++r) pmax = fmaxf(pmax, p0[r]); for (int r = 0; r < 16; ++r) pmax = fmaxf(pmax, p1[r]);
  { auto rr = __builtin_amdgcn_permlane32_swap(__float_as_uint(pmax), __float_as_uint(pmax), false, false);
    pmax = fmaxf(__uint_as_float(rr[0]), __uint_as_float(rr[1])); }
  if (__builtin_expect(__all(pmax - m_reg <= THR / SCALE), 1)) { mn = m_reg; alpha = 1.f; }
  else { mn = fmaxf(m_reg, pmax); alpha = __builtin_amdgcn_exp2f((m_reg - mn) * C); m_reg = mn; }
  float mnC = -mn * C;
  for (int r = 0; r < 16; ++r) p0[r] = fmaf(p0[r], C, mnC); for (int r = 0; r < 16; ++r) p1[r] = fmaf(p1[r], C, mnC);
  for (int r = 0; r < 16; ++r) p0[r] = __builtin_amdgcn_exp2f(p0[r]);
}
__device__ __forceinline__ void partialSM_win(f32x16& p0, f32x16& p1, float& m_reg, float& mn, float& alpha, float ef, float slope2) {
  constexpr float C = SCALE * LOG2E;
#pragma unroll
  for (int r = 0; r < 16; ++r) { const float o0 = (float)((r & 3) + 8 * (r >> 2));
    const float d0 = fabsf(ef + o0), d1 = fabsf(ef + (o0 + 32.f));
    const float t0 = fmaf(p0[r], C, -slope2 * d0), t1 = fmaf(p1[r], C, -slope2 * d1);
    p0[r] = d0 > 64.5f ? -1e30f : t0; p1[r] = d1 > 64.5f ? -1e30f : t1; }
  float pmax = p0[0]; for (int r = 1; r < 16; ++r) pmax = fmaxf(pmax, p0[r]); for (int r = 0; r < 16; ++r) pmax = fmaxf(pmax, p1[r]);
  { auto rr = __builtin_amdgcn_permlane32_swap(__float_as_uint(pmax), __float_as_uint(pmax), false, false);
    pmax = fmaxf(__uint_as_float(rr[0]), __uint_as_float(rr[1])); }
  if (__builtin_expect(__all(pmax - m_reg <= THR * LOG2E), 1)) { mn = m_reg; alpha = 1.f; }
  else { mn = fmaxf(m_reg, pmax); alpha = __builtin_amdgcn_exp2f(m_reg - mn); m_reg = mn; }
  for (int r = 0; r < 16; ++r) p0[r] = p0[r] - mn; for (int r = 0; r < 16; ++r) p1[r] = p1[r] - mn;
  for (int r = 0; r < 16; ++r) p0[r] = __builtin_amdgcn_exp2f(p0[r]);
}
__device__ __forceinline__ void finishSM(f32x16& p0, f32x16& p1, float alpha, float& l_reg, bf16x8& pa0, bf16x8& pa1, bf16x8& pa2, bf16x8& pa3) {
  for (int r = 0; r < 16; ++r) p1[r] = __builtin_amdgcn_exp2f(p1[r]);
  float ps = 0; for (int r = 0; r < 16; ++r) ps += p0[r]; for (int r = 0; r < 16; ++r) ps += p1[r];
  { auto rr = __builtin_amdgcn_permlane32_swap(__float_as_uint(ps), __float_as_uint(ps), false, false);
    ps = __uint_as_float(rr[0]) + __uint_as_float(rr[1]); }
  l_reg = l_reg * alpha + ps;
#define PK4(P, BASE, OUT) do { unsigned a0 = cvtpk(P[BASE + 0], P[BASE + 1]), a1 = cvtpk(P[BASE + 2], P[BASE + 3]);   \
    unsigned b0 = cvtpk(P[BASE + 4], P[BASE + 5]), b1 = cvtpk(P[BASE + 6], P[BASE + 7]);                              \
    auto r0 = __builtin_amdgcn_permlane32_swap(a0, b0, false, false); auto r1 = __builtin_amdgcn_permlane32_swap(a1, b1, false, false); \
    u32x4 w = {r0[0], r1[0], r0[1], r1[1]}; OUT = *reinterpret_cast<bf16x8*>(&w); } while (0)
  PK4(p0, 0, pa0); PK4(p0, 8, pa1); PK4(p1, 0, pa2); PK4(p1, 8, pa3);
#undef PK4
}
__device__ __forceinline__ void qkt(f32x16& p0, f32x16& p1, const bf16* Ks, const bf16x8* qr, int r32, int hi) {
  p0 = f32x16{}; p1 = f32x16{};
  for (int d0 = 0; d0 < 8; ++d0) { int cb = (d0 * 16 + hi * 8) * 2;
    bf16x8 b0 = *reinterpret_cast<const bf16x8*>((const char*)Ks + KSWZ(r32, cb));
    bf16x8 b1 = *reinterpret_cast<const bf16x8*>((const char*)Ks + KSWZ(32 + r32, cb));
    p0 = __builtin_amdgcn_mfma_f32_32x32x16_bf16(b0, qr[d0], p0, 0, 0, 0);
    p1 = __builtin_amdgcn_mfma_f32_32x32x16_bf16(b1, qr[d0], p1, 0, 0, 0); }
}
__device__ __forceinline__ int v_st(int k, int c) { const int kk = (k & ~0xC) | ((k & 4) << 1) | ((k & 8) >> 1); return ((kk >> 3) * 4 + (c >> 5)) * 512 + ((kk & 7) * 32 + (c & 31)) * 2; }
__device__ __forceinline__ int v_rd_base(int lane) { return ((lane & 3) << 3) | (((lane >> 2) & 3) << 6) | (((lane >> 4) & 1) << 5) | (((lane >> 5) & 1) << 8); }
constexpr int v_rd_off(int d0, int ks, int half) { return d0 * 512 + ks * 4096 + half * 2048; }
template <int OFF> __device__ __forceinline__ s16x4 tr_read(int vb) {
  s16x4 r; asm volatile("ds_read_b64_tr_b16 %0, %1 offset:%2" : "=&v"(r) : "v"(vb), "i"(OFF) : "memory"); return r;
}
template <int D0> __device__ __forceinline__ void pv_one(f32x16& od, int vb, bf16x8 pa0, bf16x8 pa1, bf16x8 pa2, bf16x8 pa3) {
  const s16x4 l0 = tr_read<v_rd_off(D0, 0, 0)>(vb), h0 = tr_read<v_rd_off(D0, 0, 1)>(vb), l1 = tr_read<v_rd_off(D0, 1, 0)>(vb), h1 = tr_read<v_rd_off(D0, 1, 1)>(vb);
  const s16x4 l2 = tr_read<v_rd_off(D0, 2, 0)>(vb), h2 = tr_read<v_rd_off(D0, 2, 1)>(vb), l3 = tr_read<v_rd_off(D0, 3, 0)>(vb), h3 = tr_read<v_rd_off(D0, 3, 1)>(vb);
  asm volatile("s_waitcnt lgkmcnt(0)" ::: "memory"); SBAR();
#define PK(L, H) (bf16x8){L[0], L[1], L[2], L[3], H[0], H[1], H[2], H[3]}
  od = __builtin_amdgcn_mfma_f32_32x32x16_bf16(pa0, PK(l0, h0), od, 0, 0, 0);
  od = __builtin_amdgcn_mfma_f32_32x32x16_bf16(pa1, PK(l1, h1), od, 0, 0, 0);
  od = __builtin_amdgcn_mfma_f32_32x32x16_bf16(pa2, PK(l2, h2), od, 0, 0, 0);
  od = __builtin_amdgcn_mfma_f32_32x32x16_bf16(pa3, PK(l3, h3), od, 0, 0, 0);
#undef PK
}
__device__ __forceinline__ void pv_d0(f32x16* o, int vb, bf16x8 pa0, bf16x8 pa1, bf16x8 pa2, bf16x8 pa3) {
  pv_one<0>(o[0], vb, pa0, pa1, pa2, pa3); pv_one<1>(o[1], vb, pa0, pa1, pa2, pa3); pv_one<2>(o[2], vb, pa0, pa1, pa2, pa3); pv_one<3>(o[3], vb, pa0, pa1, pa2, pa3);
}

template <bool WIN>
__device__ __forceinline__ void attn_unit(const bf16* __restrict__ Qb, long ldq, const bf16* __restrict__ Kh, const bf16* __restrict__ Vh, long ldk,
                                          bf16* __restrict__ Ob, long ldo, int NT, char* lds, int e0, float slope2, float* __restrict__ lse_out, long ldl, const int tid) {
  const int wid = tid >> 6, lane = tid & 63, r32 = lane & 31, hi = lane >> 5;
  bf16* V_lds = (bf16*)lds; bf16* K_lds = (bf16*)(lds + 2 * SHM_V);
  float* ws = (float*)(lds + 2 * SHM_V + 2 * SHM_K) + wid * 64; float* li_l = ws; float* al_l = ws + 32;
  float m_reg = WIN ? -1e20f : -1e30f, l_reg = 0; f32x16 o[4] = {}; bf16x8 qr[8];
  const bf16* Qw = Qb + (long)(wid * QBLK + r32) * ldq + hi * 8;
#pragma unroll
  for (int d0 = 0; d0 < 8; ++d0) qr[d0] = *reinterpret_cast<const bf16x8*>(Qw + d0 * 16);
  const int sr = tid >> 4, sc = (tid & 15) * 8, vst0 = v_st(sr, sc), vst1 = v_st(32 + sr, sc);
  const int vb0 = (int)(uintptr_t)V_lds + v_rd_base(lane);
  float ef = (float)(e0 + 4 * hi - (wid * QBLK + r32));
  struct { bf16x8 vs0, vs1, ks0, ks1; } sr_[2];
  const unsigned voff0 = (unsigned)(sr * (int)ldk + sc) * 2u, voff1 = voff0 + (unsigned)(32 * (int)ldk) * 2u;
#define SLOAD(i, k0) do { const char* vt_ = (const char*)Vh + (size_t)(k0) * (size_t)ldk * 2; const char* kt_ = (const char*)Kh + (size_t)(k0) * (size_t)ldk * 2; \
    sr_[i].vs0 = *reinterpret_cast<const bf16x8*>(vt_ + voff0); sr_[i].vs1 = *reinterpret_cast<const bf16x8*>(vt_ + voff1); \
    sr_[i].ks0 = *reinterpret_cast<const bf16x8*>(kt_ + voff0); sr_[i].ks1 = *reinterpret_cast<const bf16x8*>(kt_ + voff1); } while (0)
#define SWRITE(b, i) do { *(bf16x8*)((char*)V_lds + (b) * SHM_V + vst0) = sr_[i].vs0;          \
    *(bf16x8*)((char*)V_lds + (b) * SHM_V + vst1) = sr_[i].vs1; int kc = sc * 2;               \
    *(bf16x8*)((char*)K_lds + (b) * SHM_K + KSWZ(sr, kc)) = sr_[i].ks0;                       \
    *(bf16x8*)((char*)K_lds + (b) * SHM_K + KSWZ(32 + sr, kc)) = sr_[i].ks1; } while (0)
#define SWAIT() do { asm volatile("s_waitcnt vmcnt(4)" ::: "memory"); } while (0)
#define RESC(a) do { if (__any((a) < 1.f)) { if (hi == 0) al_l[r32] = (a); asm volatile("s_waitcnt lgkmcnt(0)" ::: "memory"); \
    for (int d = 0; d < 4; ++d) for (int r = 0; r < 16; ++r) o[d][r] *= al_l[crow(r, hi)]; } } while (0)
#define PSM(P0, P1, MN, AL) do { if constexpr (WIN) { partialSM_win(P0, P1, m_reg, MN, AL, ef, slope2); ef += 64.f; } else partialSM(P0, P1, m_reg, MN, AL); } while (0)
  f32x16 pA0, pA1, pB0, pB1; float mnA, mnB, alA, alB; bf16x8 pa0, pa1, pa2, pa3;
  constexpr int SE = 0, SO = 1;
  SLOAD(SE, 0); asm volatile("s_waitcnt vmcnt(0)" ::: "memory"); SWRITE(0, SE); __syncthreads();
  qkt(pA0, pA1, K_lds, qr, r32, hi); PSM(pA0, pA1, mnA, alA);
  SLOAD(SO, KVBLK); if (2 < NT) SLOAD(SE, 2 * KVBLK);
  SWAIT(); SWRITE(1, SO); __syncthreads();
  for (int j = 1; j + 1 < NT; j += 2) {
    SBAR(); qkt(pB0, pB1, (bf16*)((char*)K_lds + SHM_K), qr, r32, hi);
    finishSM(pA0, pA1, alA, l_reg, pa0, pa1, pa2, pa3); SBAR();
    SLOAD(SO, (j + 2) * KVBLK); SBAR();
    pv_d0(o, vb0, pa0, pa1, pa2, pa3); PSM(pB0, pB1, mnB, alB);
    __syncthreads(); SWAIT(); SWRITE(0, SE);
    RESC(alB); __syncthreads();
    SBAR(); qkt(pA0, pA1, K_lds, qr, r32, hi);
    finishSM(pB0, pB1, alB, l_reg, pa0, pa1, pa2, pa3); SBAR();
    if (j + 3 < NT) SLOAD(SE, (j + 3) * KVBLK); SBAR();
    pv_d0(o, vb0 + (int)SHM_V, pa0, pa1, pa2, pa3); PSM(pA0, pA1, mnA, alA);
    __syncthreads(); SWAIT(); SWRITE(1, SO);
    RESC(alA); __syncthreads();
  }
  SBAR(); qkt(pB0, pB1, (bf16*)((char*)K_lds + SHM_K), qr, r32, hi);
  finishSM(pA0, pA1, alA, l_reg, pa0, pa1, pa2, pa3); SBAR();
  pv_d0(o, vb0, pa0, pa1, pa2, pa3); PSM(pB0, pB1, mnB, alB);
  __syncthreads(); RESC(alB);
  finishSM(pB0, pB1, alB, l_reg, pa0, pa1, pa2, pa3); SBAR();
  pv_d0(o, vb0 + (int)SHM_V, pa0, pa1, pa2, pa3);
  if (hi == 0) li_l[r32] = l_reg; asm volatile("s_waitcnt lgkmcnt(0)" ::: "memory");
  if constexpr (WIN) { if (hi == 0) lse_out[(long)(wid * QBLK + r32) * ldl] = (m_reg + __builtin_amdgcn_logf(l_reg)) * 0.6931471805599453f; }
  float rli[16];
#pragma unroll
  for (int r = 0; r < 16; ++r) rli[r] = __builtin_amdgcn_rcpf(li_l[crow(r, hi)]);
  bf16* Ow = Ob + (long)(wid * QBLK) * ldo;
#pragma unroll
  for (int r = 0; r < 16; ++r) { int orow = crow(r, hi);
    for (int d0 = 0; d0 < 4; ++d0) Ow[(long)orow * ldo + d0 * 32 + r32] = __float2bfloat16(o[d0][r] * rli[r]); }
#undef SLOAD
#undef SWRITE
#undef SWAIT
#undef RESC
#undef PSM
}
#undef KSWZ
#undef SBAR
}
#define LAS __attribute__((address_space(3)))
#define XB_TMO      128
#define XB_XCNT(j)  (256  + 64 * (j))
#define XB_XSUB(j)  (1280 + 64 * (j))
#define XB_XGEN(j)  (2304 + 64 * (j))
#define XB_TOP      3328
#define XB_TOPGEN   3392
#define XCD_BAR_WORDS 3456
#define XB_SPIN_CAP (1u << 18)

__device__ __forceinline__ unsigned xb_ld(unsigned* p)              { return __hip_atomic_load(p, __ATOMIC_RELAXED, __HIP_MEMORY_SCOPE_AGENT); }
__device__ __forceinline__ unsigned xb_add(unsigned* p, unsigned v) { return __hip_atomic_fetch_add(p, v, __ATOMIC_RELAXED, __HIP_MEMORY_SCOPE_AGENT); }
__device__ __forceinline__ unsigned xb_xcc_id() { return (unsigned)__builtin_amdgcn_s_getreg((3 << 11) | 20) & 0xFu; }
#define XB_SPIN(cond, bar) do { unsigned _sp = 0; while (cond) { __builtin_amdgcn_s_sleep(1); \
    if ((++_sp & 255u) == 0u) { if (xb_ld(&(bar)[XB_TMO])) break; if (_sp > XB_SPIN_CAP) { atomicAdd(&(bar)[XB_TMO], 1u); break; } } } } while (0)

struct XcdBarrier {
    unsigned* bar; unsigned x;
    volatile LAS unsigned* st;
};

__device__ __forceinline__ XcdBarrier xcd_barrier_post(unsigned* bar, volatile LAS unsigned* st, bool leader) {
    XcdBarrier b; b.bar = bar; b.x = xb_xcc_id(); b.st = st;
    if (leader) (void)xb_add(&bar[XB_XCNT(b.x)], 1u);
    return b;
}
__device__ __forceinline__ void xcd_barrier_complete(unsigned* bar, unsigned x, unsigned& nloc, unsigned& nx) {
    const unsigned G = gridDim.x * gridDim.y * gridDim.z;
    unsigned sum, cnt, mine, sp = 0u;
    for (;;) {
        sum = 0u; cnt = 0u; mine = 0u;
#pragma unroll
        for (unsigned j = 0; j < 16; ++j) { const unsigned c = xb_ld(&bar[XB_XCNT(j)]); sum += c; cnt += (c > 0u) ? 1u : 0u; mine = (j == x) ? c : mine; }
        if (sum == G) break;
        __builtin_amdgcn_s_sleep(1);
        if ((++sp & 255u) == 0u) { if (xb_ld(&bar[XB_TMO])) break; if (sp > XB_SPIN_CAP) { atomicAdd(&bar[XB_TMO], 1u); break; } }
    }
    nloc = mine > 0u ? mine : 1u; nx = cnt > 0u ? cnt : 1u;
}

__device__ __forceinline__ void xcd_barrier(const XcdBarrier& b, bool leader) {
    asm volatile("s_waitcnt vmcnt(0)" ::: "memory");
    __syncthreads();
    if (leader) {
        unsigned* bar = b.bar;
        __builtin_amdgcn_s_waitcnt(0);
        unsigned nloc = b.st[0], nx = b.st[1];
        if (nloc == 0u) { xcd_barrier_complete(bar, b.x, nloc, nx); b.st[0] = nloc; b.st[1] = nx; }
        const unsigned old = xb_add(&bar[XB_XSUB(b.x)], 1u);
        const unsigned gen = old / nloc;
        if (old + 1u == (gen + 1u) * nloc) {
            __builtin_amdgcn_fence(__ATOMIC_RELEASE, "agent");
            asm volatile("s_waitcnt vmcnt(0)" ::: "memory");
            const unsigned og = xb_add(&bar[XB_TOP], 1u);
            const unsigned tg = og / nx;
            if (og + 1u == (tg + 1u) * nx) xb_add(&bar[XB_TOPGEN], 1u);
            else XB_SPIN(xb_ld(&bar[XB_TOPGEN]) == tg, bar);
            __builtin_amdgcn_fence(__ATOMIC_ACQUIRE, "agent");
            xb_add(&bar[XB_XGEN(b.x)], 1u);
            asm volatile("s_waitcnt vmcnt(0)" ::: "memory");
        } else {
            XB_SPIN(xb_ld(&bar[XB_XGEN(b.x)]) == gen, bar);
            __builtin_amdgcn_fence(__ATOMIC_ACQUIRE, "agent");
            asm volatile("s_waitcnt vmcnt(0)" ::: "memory");
        }
    }
    __syncthreads();
}

typedef unsigned short bf16u;
typedef unsigned v4u __attribute__((ext_vector_type(4)));
typedef unsigned v2u __attribute__((ext_vector_type(2)));
typedef float f32x4 __attribute__((ext_vector_type(4)));

constexpr int M = 16384, DM = 2048, SEQ = 4096, NIN = 10240, NQKV = 6144, NGATE = 4096, FF = 5632;
constexpr float ALPHA = 1.189207115002721f;
constexpr float RMS_EPS = 1e-6f, LN_EPS = 1e-5f;
constexpr int NTHR = 512, NWAVES = 8;
constexpr int LDS_BYTES = 131072 + 2048;

constexpr size_t MiB = 1u << 20;
constexpr size_t WS_WGU = 1 * MiB, WS_WDN = 45 * MiB, WS_WOUT = 67 * MiB, WS_WPA = 75 * MiB, WS_WPB = 79 * MiB;
constexpr size_t WS_WIN = 81 * MiB, WS_XB = 121 * MiB, WS_QKV = 185 * MiB, WS_G = 377 * MiB, WS_END = 505 * MiB;
constexpr size_t WS_OA = 81 * MiB, WS_OBP = 113 * MiB, WS_LSE = 161 * MiB, WS_OB = 162 * MiB;
constexpr size_t WS_MP = 185 * MiB, WS_X1B = 249 * MiB, WS_H = 313 * MiB;

struct Params {
    const float *x, *w_in, *b_gate, *qn, *kn, *wpa, *wpb, *wout, *ln1g, *ln1b, *wg, *wu, *wd, *ln2g, *ln2b;
    float* out; unsigned char* ws;
};

__device__ __forceinline__ unsigned f2bf(float f) { unsigned u = __builtin_bit_cast(unsigned, f); return (u + 0x7fffu + ((u >> 16) & 1u)) >> 16; }
__device__ __forceinline__ unsigned pk2(float lo, float hi) { return f2bf(lo) | (f2bf(hi) << 16); }
__device__ __forceinline__ float bf2f(unsigned short h) { return __uint_as_float((unsigned)h << 16); }
__device__ __forceinline__ float wave_sum(float v) {
#pragma unroll
    for (int o = 1; o < 64; o <<= 1) v += __shfl_xor(v, o);
    return v;
}

__device__ __forceinline__ void transpose_item(const float* W, int K, int N, bf16u* WT, int k0, int n0, int drow0, LAS float* scr, int lane) {
#pragma unroll 8
    for (int i = 0; i < 32; ++i) { const int kk = 2 * i + (lane >> 5); scr[kk * 33 + (lane & 31)] = W[(size_t)(k0 + kk) * N + n0 + (lane & 31)]; }
    asm volatile("s_waitcnt lgkmcnt(0)" ::: "memory");
    const int c = lane & 7;
#pragma unroll
    for (int j = 0; j < 4; ++j) { const int n = (lane >> 3) + 8 * j; const LAS float* s = scr + (8 * c) * 33 + n;
        v4u o; o.x = pk2(s[0 * 33], s[1 * 33]); o.y = pk2(s[2 * 33], s[3 * 33]); o.z = pk2(s[4 * 33], s[5 * 33]); o.w = pk2(s[6 * 33], s[7 * 33]);
        *(v4u*)(WT + (size_t)(drow0 + n) * K + k0 + 8 * c) = o; }
    asm volatile("s_waitcnt lgkmcnt(0)" ::: "memory");
}

__device__ __forceinline__ void ln_row(const float* src, const float* g, const float* b, float* dst, bf16u* dstb, int lane) {
    const f32x4* xr = (const f32x4*)src + lane;
    f32x4 v[8]; float s = 0.f;
#pragma unroll
    for (int j = 0; j < 8; ++j) { v[j] = xr[64 * j]; s += (v[j].x + v[j].y) + (v[j].z + v[j].w); }
    const float mean = wave_sum(s) * (1.f / DM); float s2 = 0.f;
#pragma unroll
    for (int j = 0; j < 8; ++j) { v[j] = v[j] - mean; s2 += (v[j].x * v[j].x + v[j].y * v[j].y) + (v[j].z * v[j].z + v[j].w * v[j].w); }
    const float rstd = 1.f / sqrtf(wave_sum(s2) * (1.f / DM) + LN_EPS);
    f32x4* o4 = (f32x4*)dst + lane;
#pragma unroll
    for (int j = 0; j < 8; ++j) { const f32x4 gg = ((const f32x4*)g)[64 * j + lane], bb = ((const f32x4*)b)[64 * j + lane];
        const f32x4 y = v[j] * rstd * gg + bb; o4[64 * j] = y;
        if (dstb) { v2u w; w.x = pk2(y.x, y.y); w.y = pk2(y.z, y.w); ((v2u*)dstb)[64 * j + lane] = w; } }
}

#ifndef REP_P0
#define REP_P0 1
#endif
#ifndef REP_A
#define REP_A 1
#endif
#ifndef REP_B
#define REP_B 1
#endif
#ifndef REP_SYNC
#define REP_SYNC 0
#endif
#ifndef REP_LN
#define REP_LN 1
#endif
__global__ void __launch_bounds__(NTHR, 2) mega_fwd(Params p) {
    extern __shared__ __attribute__((aligned(16))) unsigned char lds[];
    cg::grid_group grid = cg::this_grid();
    const int wave = __builtin_amdgcn_readfirstlane((int)threadIdx.x >> 6);
#define FRESH_LANE(L) int L; asm volatile("v_mbcnt_lo_u32_b32 %0, -1, 0\n\tv_mbcnt_hi_u32_b32 %0, -1, %0" : "=v"(L))
    const int G = gridDim.x, bx = blockIdx.x;
    const int vcu = (G % 8 == 0) ? (bx % 8) * (G / 8) + bx / 8 : bx;
    const int gw = vcu * NWAVES + wave, NGW = G * NWAVES;
    unsigned char* ws = p.ws;
    bf16u* WGU = (bf16u*)(ws + WS_WGU); bf16u* WDN = (bf16u*)(ws + WS_WDN); bf16u* WOUT = (bf16u*)(ws + WS_WOUT);
    bf16u* WPA = (bf16u*)(ws + WS_WPA); bf16u* WPB = (bf16u*)(ws + WS_WPB); bf16u* WINT = (bf16u*)(ws + WS_WIN);
    bf16u* XB = (bf16u*)(ws + WS_XB); bf16u* QKV = (bf16u*)(ws + WS_QKV); bf16u* GB = (bf16u*)(ws + WS_G);
    bf16u* OA = (bf16u*)(ws + WS_OA); bf16u* OBP = (bf16u*)(ws + WS_OBP); float* LSE = (float*)(ws + WS_LSE); bf16u* OB = (bf16u*)(ws + WS_OB);
    bf16u* MP = (bf16u*)(ws + WS_MP); bf16u* X1B = (bf16u*)(ws + WS_X1B); bf16u* HB = (bf16u*)(ws + WS_H);
    LAS unsigned char* ldsl = (LAS unsigned char*)lds;
    unsigned* barw = (unsigned*)ws;
    volatile LAS unsigned* MISC = (volatile LAS unsigned*)(ldsl + 131072 + 1024);
    { FRESH_LANE(l0); if (wave == 0 && l0 < 2) MISC[l0] = 0u; if (bx == 0) for (int i = wave * 64 + l0; i < XCD_BAR_WORDS; i += NTHR) __hip_atomic_store(barw + i, 0u, __ATOMIC_RELAXED, __HIP_MEMORY_SCOPE_AGENT); }
#define SEAM() do { FRESH_LANE(ls_); xcd_barrier(xbar, wave == 0 && ls_ == 0); } while (0)

    for (int rep_ = 0; rep_ < REP_P0; ++rep_) {
        FRESH_LANE(lane); const int tid = wave * 64 + lane;
        LAS float* scr = (LAS float*)(ldsl + wave * 8704);
        constexpr int I_IN = 32 * 320, I_G = 32 * 176, I_U = I_G, I_D = 88 * 64, I_O = 32 * 64, I_PA = 16 * 64, I_PB = 8 * 64;
        constexpr int NITEMS = I_IN + I_G + I_U + I_D + I_O + I_PA + I_PB;
        for (int it = gw; it < NITEMS; it += NGW) {
            int r = it;
            if (r < I_IN) { const int kb = r / 320, nb = r % 320; transpose_item(p.w_in, 2048, NIN, WINT, 64 * kb, 32 * nb, 32 * nb, scr, lane); continue; } r -= I_IN;
            if (r < I_G) { const int kb = r / 176, nb = r % 176, n0 = 32 * nb; transpose_item(p.wg, 2048, FF, WGU, 64 * kb, n0, 256 * (n0 >> 7) + (n0 & 127), scr, lane); continue; } r -= I_G;
            if (r < I_U) { const int kb = r / 176, nb = r % 176, n0 = 32 * nb; transpose_item(p.wu, 2048, FF, WGU, 64 * kb, n0, 256 * (n0 >> 7) + 128 + (n0 & 127), scr, lane); continue; } r -= I_U;
            if (r < I_D) { const int kb = r / 64, nb = r % 64; transpose_item(p.wd, FF, 2048, WDN, 64 * kb, 32 * nb, 32 * nb, scr, lane); continue; } r -= I_D;
            if (r < I_O) { const int kb = r / 64, nb = r % 64; transpose_item(p.wout, 2048, 2048, WOUT, 64 * kb, 32 * nb, 32 * nb, scr, lane); continue; } r -= I_O;
            if (r < I_PA) { const int kb = r / 64, nb = r % 64; transpose_item(p.wpa, 1024, 2048, WPA, 64 * kb, 32 * nb, 32 * nb, scr, lane); continue; } r -= I_PA;
            { const int kb = r / 64, nb = r % 64; transpose_item(p.wpb, 512, 2048, WPB, 64 * kb, 32 * nb, 32 * nb, scr, lane); }
        }
        const size_t n8 = (size_t)M * DM / 8;
        for (size_t i = (size_t)bx * NTHR + tid; i < n8; i += (size_t)G * NTHR) {
            const f32x4 a = ((const f32x4*)p.x)[2 * i], b = ((const f32x4*)p.x)[2 * i + 1];
            v4u o; o.x = pk2(a.x, a.y); o.y = pk2(a.z, a.w); o.z = pk2(b.x, b.y); o.w = pk2(b.z, b.w);
            ((v4u*)XB)[i] = o;
        }
    }
    grid.sync();
    XcdBarrier xbar; { FRESH_LANE(l1); xbar = xcd_barrier_post(barw, MISC, wave == 0 && l1 == 0); }

    {
        pg8::Gemm g{XB, WINT, M, NIN, DM}; pg8::StaticOrder S; S.init(M, NIN, G, bx);
        pg8::EpiQKVG E{QKV, GB, p.b_gate};
        FRESH_LANE(lane); pg8::gemm_phase<pg8::EpiQKVG, pg8::StaticOrder, true, PG8_SP2>(ldsl, g, S, E, wave * 64 + lane);
    }
    SEAM();

    {
        FRESH_LANE(lane);
        const int i = lane & 31, h2 = lane >> 5;
        const float freq = __builtin_amdgcn_exp2f(-(float)i * (13.287712379549449f / 32.f));
        const float gq0 = p.qn[i], gq1 = p.qn[i + 32], gq2 = p.qn[i + 64], gq3 = p.qn[i + 96];
        const float gk0 = p.kn[i], gk1 = p.kn[i + 32], gk2 = p.kn[i + 64], gk3 = p.kn[i + 96];
        for (int t = gw; t < M; t += NGW) {
            const int pos = t & (SEQ - 1), rid = pos >> 6, cid = pos & 63;
            float ar = (float)rid * freq * 0.15915494309189535f, ac = (float)cid * freq * 0.15915494309189535f;
            ar -= floorf(ar); ac -= floorf(ac);
            const float sr = __builtin_amdgcn_sinf(ar), cr = __builtin_amdgcn_cosf(ar), sc = __builtin_amdgcn_sinf(ac), cc = __builtin_amdgcn_cosf(ac);
#pragma unroll
            for (int it = 0; it < 5; ++it) {
                const int head = 2 * it + h2; bf16u* hp = QKV + (size_t)t * NQKV + head * 128;
                float a = bf2f(hp[i]), b = bf2f(hp[i + 32]), c = bf2f(hp[i + 64]), d = bf2f(hp[i + 96]);
                float ss = (a * a + b * b) + (c * c + d * d);
#pragma unroll
                for (int o = 1; o < 32; o <<= 1) ss += __shfl_xor(ss, o);
                const float rs = 1.f / sqrtf(ss * (1.f / 128.f) + RMS_EPS);
                const bool isq = head < 8;
                a *= rs * (isq ? gq0 : gk0); b *= rs * (isq ? gq1 : gk1); c *= rs * (isq ? gq2 : gk2); d *= rs * (isq ? gq3 : gk3);
                hp[i] = (bf16u)f2bf(a * cr - b * sr); hp[i + 32] = (bf16u)f2bf(b * cr + a * sr);
                hp[i + 64] = (bf16u)f2bf(c * cc - d * sc); hp[i + 96] = (bf16u)f2bf(d * cc + c * sc);
            }
        }
    }
    SEAM();

    {
        FRESH_LANE(lane); const int tid = wave * 64 + lane;
        const att::bf16* Q = (const att::bf16*)QKV;
        for (int rep_ = 0; rep_ < REP_A; ++rep_)
        for (int u = vcu; u < 512; u += G) {
            const int bk = u >> 6, b = bk >> 1, kvh = bk & 1, rem = u & 63, hq = kvh * 4 + (rem >> 4), qblk = rem & 15;
            const size_t row0 = (size_t)b * SEQ;
            att::attn_unit<false>(Q + (row0 + qblk * 256) * NQKV + hq * 128, NQKV, Q + row0 * NQKV + 1024 + kvh * 128, Q + row0 * NQKV + 1280 + kvh * 128, NQKV,
                                  (att::bf16*)OA + (row0 + qblk * 256) * 1024 + hq * 128, 1024, SEQ / 64, (char*)lds, 0, 0.f, nullptr, 0, tid);
        }
        FRESH_LANE(laneb); const int tidb = wave * 64 + laneb;
        for (int rep_ = 0; rep_ < REP_B; ++rep_)
        for (int u = vcu; u < 768; u += G) {
            const int g = u >> 8, idx = u & 255, b = idx >> 6, h = (idx >> 4) & 3, sub = idx & 15;
            const int dil = g == 0 ? 1 : (g == 1 ? 4 : 16), lsub = SEQ / dil;
            const int c = g == 0 ? 0 : (g == 1 ? (sub >> 2) : sub), qblk = g == 0 ? sub : (g == 1 ? (sub & 3) : 0);
            const int q0 = qblk * 256, NT = g == 2 ? 4 : 6;
            int kv0 = q0 - 64; if (kv0 > lsub - 64 * NT) kv0 = lsub - 64 * NT; if (kv0 < 0) kv0 = 0;
            const int gh = g * 4 + h;
            const float slope2 = __builtin_amdgcn_exp2f(-8.f * (float)(gh + 1) / 12.f) * (float)dil * 1.4426950408889634f;
            const size_t row0 = (size_t)b * SEQ + c;
            att::attn_unit<true>(Q + (row0 + (size_t)dil * q0) * NQKV + 1536 + gh * 128, (long)dil * NQKV,
                                 Q + (row0 + (size_t)dil * kv0) * NQKV + 3072 + gh * 128, Q + (row0 + (size_t)dil * kv0) * NQKV + 4608 + gh * 128, (long)dil * NQKV,
                                 (att::bf16*)OBP + (size_t)g * M * 512 + (row0 + (size_t)dil * q0) * 512 + h * 128, (long)dil * 512, NT, (char*)lds, kv0 - q0, slope2,
                                 LSE + (size_t)g * M * 4 + (row0 + (size_t)dil * q0) * 4 + h, (long)dil * 4, tidb);
        }
    }
    SEAM();

    {
        FRESH_LANE(lane);
        for (int t = gw; t < M; t += NGW) {
            const int h = lane >> 4;
            const float l0 = LSE[(size_t)t * 4 + h], l1 = LSE[(size_t)M * 4 + (size_t)t * 4 + h], l2 = LSE[(size_t)2 * M * 4 + (size_t)t * 4 + h];
            const float mx = fmaxf(l0, fmaxf(l1, l2));
            float w0 = __expf(l0 - mx), w1 = __expf(l1 - mx), w2 = __expf(l2 - mx); const float inv = 1.f / (w0 + w1 + w2); w0 *= inv; w1 *= inv; w2 *= inv;
            const v4u a = ((const v4u*)(OBP + (size_t)t * 512))[lane], b = ((const v4u*)(OBP + (size_t)M * 512 + (size_t)t * 512))[lane], c = ((const v4u*)(OBP + (size_t)2 * M * 512 + (size_t)t * 512))[lane];
            v4u o;
#pragma unroll
            for (int e = 0; e < 4; ++e) {
                const float lo = w0 * __uint_as_float(a[e] << 16) + w1 * __uint_as_float(b[e] << 16) + w2 * __uint_as_float(c[e] << 16);
                const float hi = w0 * __uint_as_float(a[e] & 0xffff0000u) + w1 * __uint_as_float(b[e] & 0xffff0000u) + w2 * __uint_as_float(c[e] & 0xffff0000u);
                o[e] = pk2(lo, hi); }
            ((v4u*)(OB + (size_t)t * 512))[lane] = o;
        }
        pg8::Gemm g{OA, WPA, M, DM, 1024}; pg8::StaticOrder S; S.init(M, DM, G, bx);
        pg8::EpiGateA E{p.out, GB};
        FRESH_LANE(lane2); pg8::gemm_phase<pg8::EpiGateA, pg8::StaticOrder, true, PG8_SP2>(ldsl, g, S, E, wave * 64 + lane2);
    }
    SEAM();

    {
        pg8::Gemm g{OB, WPB, M, DM, 512}; pg8::StaticOrder S; S.init(M, DM, G, bx);
        pg8::EpiGateB E{p.out, GB, MP};
        FRESH_LANE(lane2); pg8::gemm_phase<pg8::EpiGateB, pg8::StaticOrder, true, PG8_SP2>(ldsl, g, S, E, wave * 64 + lane2);
    }
    SEAM();

    {
        pg8::Gemm g{MP, WOUT, M, DM, DM}; pg8::StaticOrder S; S.init(M, DM, G, bx);
        pg8::EpiResid E{p.x, p.out, ALPHA};
        FRESH_LANE(lane2); pg8::gemm_phase<pg8::EpiResid, pg8::StaticOrder, true, PG8_SP2>(ldsl, g, S, E, wave * 64 + lane2);
    }
    SEAM();

    for (int rep_ = 0; rep_ < REP_SYNC; ++rep_) SEAM();
    for (int rep_ = 1; rep_ < REP_LN; ++rep_) { FRESH_LANE(lane); for (int t = gw; t < M; t += NGW) ln_row(p.out + (size_t)t * DM, p.ln1g, p.ln1b, (float*)(ws + WS_H) + (size_t)t * DM, X1B + (size_t)t * DM, lane); }
    { FRESH_LANE(lane); for (int t = gw; t < M; t += NGW) ln_row(p.out + (size_t)t * DM, p.ln1g, p.ln1b, p.out + (size_t)t * DM, X1B + (size_t)t * DM, lane); }
    SEAM();

    {
        pg8::Gemm g{X1B, WGU, M, 2 * FF, DM}; pg8::StaticOrder S; S.init(M, 2 * FF, G, bx);
        pg8::EpiSwiGLU E{HB};
        FRESH_LANE(lane2); pg8::gemm_phase<pg8::EpiSwiGLU, pg8::StaticOrder, true, PG8_SP2>(ldsl, g, S, E, wave * 64 + lane2);
    }
    SEAM();

    {
        pg8::Gemm g{HB, WDN, M, DM, FF}; pg8::StaticOrder S; S.init(M, DM, G, bx);
        pg8::EpiResid E{p.out, p.out, ALPHA};
        FRESH_LANE(lane2); pg8::gemm_phase<pg8::EpiResid, pg8::StaticOrder, true, PG8_SP2>(ldsl, g, S, E, wave * 64 + lane2);
    }
    SEAM();

    { FRESH_LANE(lane); for (int t = gw; t < M; t += NGW) ln_row(p.out + (size_t)t * DM, p.ln2g, p.ln2b, p.out + (size_t)t * DM, nullptr, lane); }
}

extern "C" void kernel_launch(void* const* d_in, const int* in_sizes, int n_in, void* d_out, int out_size, void* d_ws, size_t ws_size, hipStream_t stream) {
    static int grid = 0;
    if (grid == 0) {
        if (n_in != 15 || in_sizes[0] != M * DM || out_size != M * DM || ws_size < WS_END) {
            fprintf(stderr, "kernel_launch: shape mismatch n_in %d in0 %d out %d ws %zu (need %zu)\n", n_in, n_in > 0 ? in_sizes[0] : -1, out_size, ws_size, (size_t)WS_END); grid = -1; return; }
        int dev = 0, cus = 0, per_cu = 0;
        hipGetDevice(&dev); hipDeviceGetAttribute(&cus, hipDeviceAttributeMultiprocessorCount, dev);
        if (hipFuncSetAttribute((const void*)mega_fwd, hipFuncAttributeMaxDynamicSharedMemorySize, LDS_BYTES) != hipSuccess) { fprintf(stderr, "kernel_launch: hipFuncSetAttribute failed\n"); grid = -1; return; }
        if (hipOccupancyMaxActiveBlocksPerMultiprocessor(&per_cu, (const void*)mega_fwd, NTHR, LDS_BYTES) != hipSuccess || per_cu < 1) { fprintf(stderr, "kernel_launch: occupancy query gave %d\n", per_cu); per_cu = 1; }
        (void)hipGetLastError();
        grid = cus * per_cu;
    }
    if (grid < 0) return;
    Params p{};
    p.x = (const float*)d_in[0]; p.w_in = (const float*)d_in[1]; p.b_gate = (const float*)d_in[2]; p.qn = (const float*)d_in[3]; p.kn = (const float*)d_in[4];
    p.wpa = (const float*)d_in[5]; p.wpb = (const float*)d_in[6]; p.wout = (const float*)d_in[7]; p.ln1g = (const float*)d_in[8]; p.ln1b = (const float*)d_in[9];
    p.wg = (const float*)d_in[10]; p.wu = (const float*)d_in[11]; p.wd = (const float*)d_in[12]; p.ln2g = (const float*)d_in[13]; p.ln2b = (const float*)d_in[14];
    p.out = (float*)d_out; p.ws = (unsigned char*)d_ws;
    void* args[] = {&p};
    hipError_t e = hipLaunchCooperativeKernel((const void*)mega_fwd, dim3(grid), dim3(NTHR), args, LDS_BYTES, stream);
    if (e != hipSuccess) fprintf(stderr, "kernel_launch: cooperative launch failed: %s (grid %d)\n", hipGetErrorString(e), grid);
}
```

```cpp
#include <hip/hip_runtime.h>
#include <hip/hip_bf16.h>
#include <hip/hip_cooperative_groups.h>
#include <cstdio>
#include <cstdint>
#include <cmath>
namespace cg = cooperative_groups;
namespace pg8 {
#define PG8_LAS __attribute__((address_space(3)))
typedef unsigned short bf16_t;
typedef short bf16x8 __attribute__((ext_vector_type(8)));
typedef float f32x4 __attribute__((ext_vector_type(4)));
typedef unsigned u32x4 __attribute__((ext_vector_type(4)));
typedef int i32x4 __attribute__((ext_vector_type(4)));
typedef int i32x8 __attribute__((ext_vector_type(8)));
constexpr int BM = 256, BK = 64, HALF = 128, HTB = HALF * BK * 2  , STAGE_BYTES = 8 * HTB, NXCD = 8, WGM = 8;

__host__ __device__ __forceinline__ int lds_byte(int r, int c) { const int st = (r >> 4) * 2 + (c >> 5), rr = r & 15, cc = c & 31, ob = rr * 64 + cc * 2; return st * 1024 + (ob ^ (((ob >> 9) & 1) << 5)); }
__host__ __device__ __forceinline__ void stage_rc(int b, int& R, int& C) { const int st = b / 1024, sb = b % 1024, swz = sb ^ (((sb >> 9) & 1) << 5); R = (st >> 1) * 16 + swz / 64; C = (st & 1) * 32 + (swz % 64) / 2; }
__host__ __device__ __forceinline__ int perm32(int rho) { const int n = rho >> 4, i = rho & 15; return 8 * (i >> 2) + 4 * n + (i & 3); }

struct Unit { int pm, pn; };
struct Gemm { const bf16_t* A; const bf16_t* Bt; int M, N, K; };

struct StaticOrder {
    int nM, nN, nwg, G, c;
    __host__ __device__ void init(int M, int N, int G_, int c_) { nM = M / BM; nN = N / BM; nwg = nM * nN; G = G_; c = c_; }
    __host__ __device__ bool next(int i, Unit& u) const {
        const long L = (long)i * G + c; if (L >= nwg) return false;
        int wgid = (int)L; { const int q = nwg / NXCD, r = nwg % NXCD, xcd = wgid % NXCD, off = wgid / NXCD; wgid = (xcd < r ? xcd * (q + 1) : r * (q + 1) + (xcd - r) * q) + off; }
        const int nig = WGM * nN, gid = wgid / nig, fm = gid * WGM, gsz = (nM - fm) < WGM ? (nM - fm) : WGM;
        u.pm = fm + ((wgid % nig) % gsz); u.pn = (wgid % nig) / gsz; return true;
    }
    __device__ __forceinline__ void a_ready(const Unit&) const {}
    __device__ __forceinline__ void done(const Unit&) const {}
};

typedef float f32x2_t __attribute__((ext_vector_type(2))); typedef __bf16 bf16x2_t __attribute__((ext_vector_type(2)));
__device__ __forceinline__ unsigned cvt_pk_bf16(float lo, float hi) { f32x2_t v = {lo, hi}; bf16x2_t b = __builtin_convertvector(v, bf16x2_t); return __builtin_bit_cast(unsigned, b); }
typedef float f32x2 __attribute__((ext_vector_type(2)));
typedef unsigned u32x2 __attribute__((ext_vector_type(2)));
__device__ __forceinline__ float sigmoid_f(float x) { return __builtin_amdgcn_rcpf(1.0f + __builtin_amdgcn_exp2f(-1.4426950408889634f * x)); }
__device__ __forceinline__ float bf_lo(unsigned w) { return __uint_as_float(w << 16); }
__device__ __forceinline__ float bf_hi(unsigned w) { return __uint_as_float(w & 0xffff0000u); }

struct EpiQKVG {
    static constexpr bool PERM = true, AFTER_DRAIN = false;
    bf16_t* QKV; bf16_t* G; const float* bgate; float sc;
    __device__ __forceinline__ void operator()(const f32x4 (&acc)[2][2][4][2], const Unit& u, int wr, int wc, int fr, int fq) const {
        const int row0 = u.pm * BM + wr * 64 + fr;
        if (u.pn < 24) {
            const int col0 = u.pn * BM + wc * 32 + 8 * fq;
#pragma unroll
            for (int ai = 0; ai < 2; ++ai)
#pragma unroll
                for (int m = 0; m < 4; ++m) { bf16_t* rowp = QKV + (size_t)(row0 + ai * HALF + m * 16) * 6144 + col0;
#pragma unroll
                    for (int bj = 0; bj < 2; ++bj) { const f32x4 v0 = acc[ai][bj][m][0] * sc, v1 = acc[ai][bj][m][1] * sc;
                        u32x4 w; w.x = cvt_pk_bf16(v0[0], v0[1]); w.y = cvt_pk_bf16(v0[2], v0[3]); w.z = cvt_pk_bf16(v1[0], v1[1]); w.w = cvt_pk_bf16(v1[2], v1[3]);
                        *(u32x4*)(rowp + bj * HALF) = w; } }
        } else {
            const int col0 = (u.pn - 24) * BM + wc * 32 + 8 * fq;
            f32x4 bv[2][2];
#pragma unroll
            for (int bj = 0; bj < 2; ++bj)
#pragma unroll
                for (int n = 0; n < 2; ++n) bv[bj][n] = *(const f32x4*)(bgate + col0 + bj * HALF + 4 * n);
#pragma unroll
            for (int ai = 0; ai < 2; ++ai)
#pragma unroll
                for (int m = 0; m < 4; ++m) { bf16_t* rowp = G + (size_t)(row0 + ai * HALF + m * 16) * 4096 + col0;
#pragma unroll
                    for (int bj = 0; bj < 2; ++bj) { f32x4 v0 = acc[ai][bj][m][0] * sc + bv[bj][0], v1 = acc[ai][bj][m][1] * sc + bv[bj][1];
#pragma unroll
                        for (int e = 0; e < 4; ++e) { v0[e] = sigmoid_f(v0[e]); v1[e] = sigmoid_f(v1[e]); }
                        u32x4 w; w.x = cvt_pk_bf16(v0[0], v0[1]); w.y = cvt_pk_bf16(v0[2], v0[3]); w.z = cvt_pk_bf16(v1[0], v1[1]); w.w = cvt_pk_bf16(v1[2], v1[3]);
                        *(u32x4*)(rowp + bj * HALF) = w; } }
        }
    }
};

struct EpiGateA {
    static constexpr bool PERM = false, AFTER_DRAIN = false;
    float* T; const bf16_t* G;
    __device__ __forceinline__ void operator()(const f32x4 (&acc)[2][2][4][2], const Unit& u, int wr, int wc, int fr, int fq) const {
        const int row0 = u.pm * BM + wr * 64 + fr, col0 = u.pn * BM + wc * 32 + 4 * fq;
#pragma unroll
        for (int ai = 0; ai < 2; ++ai)
#pragma unroll
            for (int m = 0; m < 4; ++m) { const size_t r = (size_t)(row0 + ai * HALF + m * 16);
#pragma unroll
                for (int bj = 0; bj < 2; ++bj)
#pragma unroll
                    for (int n = 0; n < 2; ++n) { const int c = col0 + bj * HALF + n * 16;
                        const u32x2 g = *(const u32x2*)(G + r * 4096 + c); const f32x4 a = acc[ai][bj][m][n];
                        f32x4 o; o[0] = a[0] * bf_lo(g.x); o[1] = a[1] * bf_hi(g.x); o[2] = a[2] * bf_lo(g.y); o[3] = a[3] * bf_hi(g.y);
                        *(f32x4*)(T + r * 2048 + c) = o; }
                if (m & 1) asm volatile("" ::: "memory"); }
    }
};

struct EpiGateB {
    static constexpr bool PERM = true, AFTER_DRAIN = false;
    const float* T; const bf16_t* G; bf16_t* MP;
    __device__ __forceinline__ void operator()(const f32x4 (&acc)[2][2][4][2], const Unit& u, int wr, int wc, int fr, int fq) const {
        const int row0 = u.pm * BM + wr * 64 + fr, col0 = u.pn * BM + wc * 32 + 8 * fq;
#pragma unroll
        for (int ai = 0; ai < 2; ++ai)
#pragma unroll
            for (int m = 0; m < 4; ++m) { const size_t r = (size_t)(row0 + ai * HALF + m * 16);
#pragma unroll
                for (int bj = 0; bj < 2; ++bj) { const int c = col0 + bj * HALF;
                    const u32x4 g = *(const u32x4*)(G + r * 4096 + 2048 + c);
                    const f32x4 t0 = *(const f32x4*)(T + r * 2048 + c), t1 = *(const f32x4*)(T + r * 2048 + c + 4);
                    const f32x4 a0 = acc[ai][bj][m][0], a1 = acc[ai][bj][m][1];
                    u32x4 w;
                    w.x = cvt_pk_bf16(t0[0] + a0[0] * bf_lo(g.x), t0[1] + a0[1] * bf_hi(g.x));
                    w.y = cvt_pk_bf16(t0[2] + a0[2] * bf_lo(g.y), t0[3] + a0[3] * bf_hi(g.y));
                    w.z = cvt_pk_bf16(t1[0] + a1[0] * bf_lo(g.z), t1[1] + a1[1] * bf_hi(g.z));
                    w.w = cvt_pk_bf16(t1[2] + a1[2] * bf_lo(g.w), t1[3] + a1[3] * bf_hi(g.w));
                    *(u32x4*)(MP + r * 2048 + c) = w; }
                if (m & 1) asm volatile("" ::: "memory"); }
    }
};

struct EpiResid {
    static constexpr bool PERM = false, AFTER_DRAIN = false;
    const float* base; float* out; float alpha;
    __device__ __forceinline__ void operator()(const f32x4 (&acc)[2][2][4][2], const Unit& u, int wr, int wc, int fr, int fq) const {
        const int row0 = u.pm * BM + wr * 64 + fr, col0 = u.pn * BM + wc * 32 + 4 * fq;
#pragma unroll
        for (int ai = 0; ai < 2; ++ai)
#pragma unroll
            for (int m = 0; m < 4; ++m) { const size_t r = (size_t)(row0 + ai * HALF + m * 16);
#pragma unroll
                for (int bj = 0; bj < 2; ++bj)
#pragma unroll
                    for (int n = 0; n < 2; ++n) { const int c = col0 + bj * HALF + n * 16;
                        const f32x4 b = *(const f32x4*)(base + r * 2048 + c);
                        *(f32x4*)(out + r * 2048 + c) = b * alpha + acc[ai][bj][m][n]; }
                if (m & 1) asm volatile("" ::: "memory"); }
    }
};

struct EpiSwiGLU {
    static constexpr bool PERM = true, AFTER_DRAIN = false;
    bf16_t* H;
    __device__ __forceinline__ void operator()(const f32x4 (&acc)[2][2][4][2], const Unit& u, int wr, int wc, int fr, int fq) const {
        const int row0 = u.pm * BM + wr * 64 + fr, col0 = u.pn * HALF + wc * 32 + 8 * fq;
#pragma unroll
        for (int ai = 0; ai < 2; ++ai)
#pragma unroll
            for (int m = 0; m < 4; ++m) { bf16_t* rowp = H + (size_t)(row0 + ai * HALF + m * 16) * 5632 + col0;
                f32x4 h0, h1;
#pragma unroll
                for (int e = 0; e < 4; ++e) { const float g0 = acc[ai][0][m][0][e], g1 = acc[ai][0][m][1][e];
                    h0[e] = g0 * sigmoid_f(g0) * acc[ai][1][m][0][e]; h1[e] = g1 * sigmoid_f(g1) * acc[ai][1][m][1][e]; }
                u32x4 w; w.x = cvt_pk_bf16(h0[0], h0[1]); w.y = cvt_pk_bf16(h0[2], h0[3]); w.z = cvt_pk_bf16(h1[0], h1[1]); w.w = cvt_pk_bf16(h1[2], h1[3]);
                *(u32x4*)rowp = w; }
    }
};

template <class Epi, class Sched, bool ALIGN_EPI = false, bool SP2 = false, bool F8 = false>
__device__ __forceinline__ void gemm_phase(PG8_LAS unsigned char* lds, const Gemm g, const Sched& S, const Epi& E, const int tid  ) {
    const int wid = __builtin_amdgcn_readfirstlane(tid >> 6), lane = tid & 63, wr = wid >> 2, wc = wid & 3, fr = lane & 15, fq = lane >> 4;
    const int K = F8 ? g.K / 2 : g.K, nt = K / BK;
    unsigned voffA[2], voffB[2];
#pragma unroll
    for (int i = 0; i < 2; ++i) { int R, C; stage_rc(tid * 16 + i * 8192, R, C); const int Rb = Epi::PERM ? ((R & ~31) + perm32(R & 31)) : R;
        voffA[i] = (unsigned)(R * K + C) * 2u; voffB[i] = (unsigned)(Rb * K + C) * 2u; }
    const size_t kstep = (size_t)(BK * 2);
    const size_t hstep = (size_t)HALF * K * 2;
    const size_t tstep = 2 * hstep;
    const unsigned ldsw = (unsigned)wid * 1024u;
    const int aoff = lds_byte(wr * 64 + fr, fq * 8), boff = lds_byte(wc * 32 + fr, fq * 8);
#define PG8_SA(b, h) (((b) * 2 + (h)) * HTB)
#define PG8_SB(b, h) ((4 + (b) * 2 + (h)) * HTB)
#define PG8_STAGE(bufoff, gbase, voff) do { _Pragma("unroll") for (int _i = 0; _i < 2; ++_i) \
        __builtin_amdgcn_global_load_lds((const unsigned*)((const char*)(gbase) + (voff)[_i]), (PG8_LAS unsigned*)(lds + (bufoff) + ldsw + _i * 8192), 16, 0, 0); } while (0)
#define PG8_LDA(dst, b, h) do { _Pragma("unroll") for (int m = 0; m < 4; ++m) { if constexpr (F8) { dst##8[m].lo = *(const PG8_LAS i32x4*)(lds + PG8_SA(b, h) + aoff + m * 2048); dst##8[m].hi = *(const PG8_LAS i32x4*)(lds + PG8_SA(b, h) + aoff + m * 2048 + 1024); } \
        else { _Pragma("unroll") for (int k = 0; k < 2; ++k) dst[m][k] = *(const PG8_LAS bf16x8*)(lds + PG8_SA(b, h) + aoff + m * 2048 + k * 1024); } } } while (0)
#define PG8_LDB(dst, b, h) do { _Pragma("unroll") for (int n = 0; n < 2; ++n) { if constexpr (F8) { dst##8[n].lo = *(const PG8_LAS i32x4*)(lds + PG8_SB(b, h) + boff + n * 2048); dst##8[n].hi = *(const PG8_LAS i32x4*)(lds + PG8_SB(b, h) + boff + n * 2048 + 1024); } \
        else { _Pragma("unroll") for (int k = 0; k < 2; ++k) dst[n][k] = *(const PG8_LAS bf16x8*)(lds + PG8_SB(b, h) + boff + n * 2048 + k * 1024); } } } while (0)
#define PG8_MMA(ai, bj, At, Bt) do { __builtin_amdgcn_s_setprio(1); _Pragma("unroll") for (int m = 0; m < 4; ++m) _Pragma("unroll") for (int n = 0; n < 2; ++n) { \
        if constexpr (F8) asm volatile("v_mfma_f32_16x16x128_f8f6f4 %0, %1, %2, %0" : "+v"(acc[ai][bj][m][n]) : "v"(Bt##8[n]), "v"(At##8[m]));   \
        else { _Pragma("unroll") for (int k = 0; k < 2; ++k) acc[ai][bj][m][n] = __builtin_amdgcn_mfma_f32_16x16x32_bf16(Bt[n][k], At[m][k], acc[ai][bj][m][n], 0, 0, 0); } } __builtin_amdgcn_s_setprio(0); } while (0)
#define PG8_WAIT_V(n) asm volatile("s_waitcnt vmcnt(" #n ")" ::: "memory")
#define PG8_WAIT_L(n) asm volatile("s_waitcnt lgkmcnt(" #n ")" ::: "memory")
#define PG8_BAR __builtin_amdgcn_s_barrier()
#define PG8_SCHED __builtin_amdgcn_sched_barrier(0)
    Unit cur, nxt; int ui = 0;
    if (!S.next(0, cur)) return;
    f32x4 acc[2][2][4][2];
#pragma unroll
    for (int a = 0; a < 2; ++a)
#pragma unroll
        for (int b = 0; b < 2; ++b)
#pragma unroll
            for (int m = 0; m < 4; ++m)
#pragma unroll
                for (int n = 0; n < 2; ++n) acc[a][b][m][n] = (f32x4){0.f, 0.f, 0.f, 0.f};
    bf16x8 At[4][2], B0[2][2], B1[2][2];
    i32x8 At8[4], B08[2], B18[2];
    const char* cA = (const char*)g.A + (size_t)cur.pm * tstep; const char* cB = (const char*)g.Bt + (size_t)cur.pn * tstep;
    S.a_ready(cur);
    if constexpr (SP2) {
        PG8_STAGE(PG8_SB(0, 0), cB, voffB); PG8_STAGE(PG8_SB(0, 1), cB + hstep, voffB); PG8_STAGE(PG8_SA(0, 0), cA, voffA); PG8_STAGE(PG8_SA(0, 1), cA + hstep, voffA);
        if (wr == 1) PG8_BAR;
        PG8_WAIT_V(2); PG8_BAR;
        PG8_STAGE(PG8_SB(1, 0), cB + kstep, voffB); PG8_STAGE(PG8_SA(1, 0), cA + kstep, voffA); PG8_STAGE(PG8_SB(1, 1), cB + hstep + kstep, voffB);
        PG8_WAIT_V(6); PG8_BAR;
    } else {
        PG8_STAGE(PG8_SB(0, 0), cB, voffB); PG8_STAGE(PG8_SA(0, 0), cA, voffA); PG8_STAGE(PG8_SB(0, 1), cB + hstep, voffB); PG8_STAGE(PG8_SA(0, 1), cA + hstep, voffA);
        if (wr == 1) PG8_BAR;
        PG8_WAIT_V(4); PG8_BAR;
        PG8_STAGE(PG8_SB(1, 0), cB + kstep, voffB); PG8_STAGE(PG8_SA(1, 0), cA + kstep, voffA); PG8_STAGE(PG8_SB(1, 1), cB + hstep + kstep, voffB);
        PG8_WAIT_V(6); PG8_BAR;
    }
    for (;;) {
        const bool has_next = S.next(ui + 1, nxt);
        const char* nA = has_next ? (const char*)g.A + (size_t)nxt.pm * tstep : cA; const char* nB = has_next ? (const char*)g.Bt + (size_t)nxt.pn * tstep : cB;
        for (int t = 0; t < nt; t += 2) {
            const bool last = (t == nt - 2);
            const char* a1 = cA + (size_t)(t + 1) * kstep;
            const char* a2 = last ? nA : cA + (size_t)(t + 2) * kstep; const char* b2 = last ? nB : cB + (size_t)(t + 2) * kstep;
            const char* a3 = a2 + kstep; const char* b3 = b2 + kstep;
            if (last && has_next) S.a_ready(nxt);
            if constexpr (SP2) {
            PG8_LDB(B0, 0, 0); PG8_LDB(B1, 0, 1); PG8_SCHED; PG8_LDA(At, 0, 0); PG8_STAGE(PG8_SA(1, 1), a1 + hstep, voffA);
            PG8_WAIT_V(8); PG8_WAIT_L(0); PG8_BAR; PG8_MMA(0, 0, At, B0); PG8_MMA(0, 1, At, B1); PG8_BAR; PG8_SCHED;
            PG8_LDA(At, 0, 1); PG8_STAGE(PG8_SB(0, 0), b2, voffB); PG8_STAGE(PG8_SB(0, 1), b2 + hstep, voffB); PG8_STAGE(PG8_SA(0, 0), a2, voffA);
            PG8_WAIT_V(8); PG8_WAIT_L(0); PG8_BAR; PG8_MMA(1, 0, At, B0); PG8_MMA(1, 1, At, B1); PG8_BAR; PG8_SCHED;
            PG8_LDB(B0, 1, 0); PG8_LDB(B1, 1, 1); PG8_SCHED; PG8_LDA(At, 1, 0); PG8_STAGE(PG8_SA(0, 1), a2 + hstep, voffA);
            PG8_WAIT_V(8); PG8_WAIT_L(0); PG8_BAR; PG8_MMA(0, 0, At, B0); PG8_MMA(0, 1, At, B1); PG8_BAR; PG8_SCHED;
            PG8_LDA(At, 1, 1); PG8_STAGE(PG8_SB(1, 0), b3, voffB); PG8_STAGE(PG8_SB(1, 1), b3 + hstep, voffB); PG8_STAGE(PG8_SA(1, 0), a3, voffA);
            PG8_WAIT_V(8); PG8_WAIT_L(0); PG8_BAR; PG8_MMA(1, 0, At, B0); PG8_MMA(1, 1, At, B1); PG8_BAR; PG8_SCHED;
            } else {
            PG8_LDB(B0, 0, 0); PG8_SCHED; PG8_LDA(At, 0, 0); PG8_STAGE(PG8_SA(1, 1), a1 + hstep, voffA);
            PG8_WAIT_L(8); PG8_BAR; PG8_WAIT_L(0); PG8_MMA(0, 0, At, B0); PG8_BAR; PG8_SCHED;
            PG8_LDB(B1, 0, 1); PG8_STAGE(PG8_SB(0, 0), b2, voffB);
            PG8_BAR; PG8_WAIT_L(0); PG8_MMA(0, 1, At, B1); PG8_BAR;
            PG8_LDA(At, 0, 1); PG8_STAGE(PG8_SA(0, 0), a2, voffA);
            PG8_BAR; PG8_WAIT_L(0); PG8_MMA(1, 0, At, B0); PG8_BAR; PG8_SCHED;
            PG8_STAGE(PG8_SB(0, 1), b2 + hstep, voffB);
            PG8_WAIT_V(6); PG8_BAR; PG8_MMA(1, 1, At, B1); PG8_BAR;
            PG8_LDB(B0, 1, 0); PG8_SCHED; PG8_LDA(At, 1, 0); PG8_STAGE(PG8_SA(0, 1), a2 + hstep, voffA);
            PG8_WAIT_L(8); PG8_BAR; PG8_WAIT_L(0); PG8_MMA(0, 0, At, B0); PG8_BAR; PG8_SCHED;
            PG8_LDB(B1, 1, 1); PG8_STAGE(PG8_SB(1, 0), b3, voffB);
            PG8_BAR; PG8_WAIT_L(0); PG8_MMA(0, 1, At, B1); PG8_BAR;
            PG8_LDA(At, 1, 1); PG8_STAGE(PG8_SA(1, 0), a3, voffA);
            PG8_BAR; PG8_WAIT_L(0); PG8_MMA(1, 0, At, B0); PG8_BAR; PG8_SCHED;
            PG8_STAGE(PG8_SB(1, 1), b3 + hstep, voffB);
            PG8_WAIT_V(6); PG8_BAR; PG8_MMA(1, 1, At, B1); PG8_BAR;
            }
        }
        if constexpr (F8) asm volatile("s_nop 15\n\ts_nop 15" ::: "memory");
        if constexpr (ALIGN_EPI) { if (wr == 0) PG8_BAR; }
        if constexpr (!Epi::AFTER_DRAIN) { E(acc, cur, wr, wc, fr, fq); S.done(cur); }
        if (!has_next) break;
#pragma unroll
        for (int a = 0; a < 2; ++a)
#pragma unroll
            for (int b = 0; b < 2; ++b)
#pragma unroll
                for (int m = 0; m < 4; ++m)
#pragma unroll
                    for (int n = 0; n < 2; ++n) acc[a][b][m][n] = (f32x4){0.f, 0.f, 0.f, 0.f};
        cur = nxt; cA = nA; cB = nB; ++ui;
        if constexpr (ALIGN_EPI) { if (wr == 1) PG8_BAR; }
    }
    PG8_WAIT_V(0);
    if constexpr (!ALIGN_EPI) { if (wr == 0) PG8_BAR; }
    PG8_BAR;
    if constexpr (Epi::AFTER_DRAIN) { E.fused(acc, cur, wr, wc, fr, fq, lds, wid, lane); S.done(cur); }
#undef PG8_SA
#undef PG8_SB
#undef PG8_STAGE
#undef PG8_LDA
#undef PG8_LDB
#undef PG8_MMA
#undef PG8_WAIT_V
#undef PG8_WAIT_L
#undef PG8_BAR
#undef PG8_SCHED
}
}

#ifndef PG8_SP2
#define PG8_SP2 true
#endif
namespace att {
using bf16 = __hip_bfloat16;
constexpr int D = 128, NW = 8, QBLK = 32, KVBLK = 64;
constexpr float SCALE = 0.088388347648318440f;
constexpr float THR = 8.f;
constexpr float LOG2E = 1.4426950408889634f;
constexpr size_t SHM_V = KVBLK * D * 2, SHM_K = KVBLK * D * 2, SHM_ATTN = 2 * SHM_V + 2 * SHM_K + NW * 64 * 4;
using bf16x8 = __attribute__((ext_vector_type(8))) short;
using s16x4  = __attribute__((ext_vector_type(4))) short;
using f32x16 = __attribute__((ext_vector_type(16))) float;
using u32x4  = __attribute__((ext_vector_type(4))) unsigned;
#define KSWZ(row, colB) ((row) * 256 + ((colB) ^ (((row) & 7) << 4)))
#define SBAR() __builtin_amdgcn_sched_barrier(0)
__device__ __forceinline__ int crow(int r, int hi) { return (r & 3) + 8 * (r >> 2) + 4 * hi; }
__device__ __forceinline__ unsigned cvtpk(float lo, float hi) { return pg8::cvt_pk_bf16(lo, hi); }
__device__ __forceinline__ void partialSM(f32x16& p0, f32x16& p1, float& m_reg, float& mn, float& alpha) {
  constexpr float C = SCALE * LOG2E;
  float pmax = p0[0]; for (int r = 1; r < 16; ++r) pmax = fmaxf(pmax, p0[r]); for (int r = 0; r < 16; ++r) pmax = fmaxf(pmax, p1[r]);
  { auto rr = __builtin_amdgcn_permlane32_swap(__float_as_uint(pmax), __float_as_uint(pmax), false, false);
    pmax = fmaxf(__uint_as_float(rr[0]), __uint_as_float(rr[1])); }
  if (__builtin_expect(__all(pmax - m_reg <= THR / SCALE), 1)) { mn = m_reg; alpha = 1.f; }
  else { mn = fmaxf(m_reg, pmax); alpha = __builtin_amdgcn_exp2f((m_reg - mn) * C); m_reg = mn; }
  float mnC = -mn * C;
  for (int r = 0; r < 16; ++r) p0[r] = fmaf(p0[r], C, mnC); for (int r = 0; r < 16; ++r) p1[r] = fmaf(p1[r], C, mnC);
  for (int r = 0; r < 16; ++r) p0[r] = __builtin_amdgcn_exp2f(p0[r]);
}
__device__ __forceinline__ void partialSM_win(f32x16& p0, f32x16& p1, float& m_reg, float& mn, float& alpha, float ef, float slope2) {
  constexpr float C = SCALE * LOG2E;
#pragma unroll
  for (int r = 0; r < 16; ++r) { const float o0 = (float)((r & 3) + 8 * (r >> 2));
    const float d0 = fabsf(ef + o0), d1 = fabsf(ef + (o0 + 32.f));
    const float t0 = fmaf(p0[r], C, -slope2 * d0), t1 = fmaf(p1[r], C, -slope2 * d1);
    p0[r] = d0 > 64.5f ? -1e30f : t0; p1[r] = d1 > 64.5f ? -1e30f : t1; }
  float pmax = p0[0]; for (int r = 1; r < 16; ++r) pmax = fmaxf(pmax, p0[r]); for (int r = 0; r < 16; ++r) pmax = fmaxf(pmax, p1[r]);
  { auto rr = __builtin_amdgcn_permlane32_swap(__float_as_uint(pmax), __float_as_uint(pmax), false, false);
    pmax = fmaxf(__uint_as_float(rr[0]), __uint_as_float(rr[1])); }
  if (__builtin_expect(__all(pmax - m_reg <= THR * LOG2E), 1)) { mn = m_reg; alpha = 1.f; }
  else { mn = fmaxf(m_reg, pmax); alpha = __builtin_amdgcn_exp2f(m_reg - mn); m_reg = mn; }
  for (int r = 0; r < 16; ++r) p0[r] = p0[r] - mn; for (int r = 0; r < 16; ++r) p1[r] = p1[r] - mn;
  for (int r = 0; r < 16; ++r) p0[r] = __builtin_amdgcn_exp2f(p0[r]);
}
__device__ __forceinline__ void finishSM(f32x16& p0, f32x16& p1, float alpha, float& l_reg, bf16x8& pa0, bf16x8& pa1, bf16x8& pa2, bf16x8& pa3) {
  for (int r = 0; r < 16; ++r) p1[r] = __builtin_amdgcn_exp2f(p1[r]);
  float ps = 0; for (int r = 0; r < 16; ++r) ps += p0[r]; for (int r = 0; r < 16; ++r) ps += p1[r];
  { auto rr = __builtin_amdgcn_permlane32_swap(__float_as_uint(ps), __float_as_uint(ps), false, false);
    ps = __uint_as_float(rr[0]) + __uint_as_float(rr[1]); }
  l_reg = l_reg * alpha + ps;
#define PK4(P, BASE, OUT) do { unsigned a0 = cvtpk(P[BASE + 0], P[BASE + 1]), a1 = cvtpk(P[BASE + 2], P[BASE + 3]);   \
    unsigned b0 = cvtpk(P[BASE + 4], P[BASE + 5]), b1 = cvtpk(P[BASE + 6], P[BASE + 7]);                              \
    auto r0 = __builtin_amdgcn_permlane32_swap(a0, b0, false, false); auto r1 = __builtin_amdgcn_permlane32_swap(a1, b1, false, false); \
    u32x4 w = {r0[0], r1[0], r0[1], r1[1]}; OUT = *reinterpret_cast<bf16x8*>(&w); } while (0)
  PK4(p0, 0, pa0); PK4(p0, 8, pa1); PK4(p1, 0, pa2); PK4(p1, 8, pa3);
#undef PK4
}
__device__ __forceinline__ void qkt(f32x16& p0, f32x16& p1, const bf16* Ks, const bf16x8* qr, int r32, int hi) {
  p0 = f32x16{}; p1 = f32x16{};
  for (int d0 = 0; d0 < 8; ++d0) { int cb = (d0 * 16 + hi * 8) * 2;
    bf16x8 b0 = *reinterpret_cast<const bf16x8*>((const char*)Ks + KSWZ(r32, cb));
    bf16x8 b1 = *reinterpret_cast<const bf16x8*>((const char*)Ks + KSWZ(32 + r32, cb));
    p0 = __builtin_amdgcn_mfma_f32_32x32x16_bf16(b0, qr[d0], p0, 0, 0, 0);
    p1 = __builtin_amdgcn_mfma_f32_32x32x16_bf16(b1, qr[d0], p1, 0, 0, 0); }
}
__device__ __forceinline__ int v_st(int k, int c) { const int kk = (k & ~0xC) | ((k & 4) << 1) | ((k & 8) >> 1); return ((kk >> 3) * 4 + (c >> 5)) * 512 + ((kk & 7) * 32 + (c & 31)) * 2; }
__device__ __forceinline__ int v_rd_base(int lane) { return ((lane & 3) << 3) | (((lane >> 2) & 3) << 6) | (((lane >> 4) & 1) << 5) | (((lane >> 5) & 1) << 8); }
constexpr int v_rd_off(int d0, int ks, int half) { return d0 * 512 + ks * 4096 + half * 2048; }
template <int OFF> __device__ __forceinline__ s16x4 tr_read(int vb) {
  s16x4 r; asm volatile("ds_read_b64_tr_b16 %0, %1 offset:%2" : "=&v"(r) : "v"(vb), "i"(OFF) : "memory"); return r;
}
template <int D0> __device__ __forceinline__ void pv_one(f32x16& od, int vb, bf16x8 pa0, bf16x8 pa1, bf16x8 pa2, bf16x8 pa3) {
  const s16x4 l0 = tr_read<v_rd_off(D0, 0, 0)>(vb), h0 = tr_read<v_rd_off(D0, 0, 1)>(vb), l1 = tr_read<v_rd_off(D0, 1, 0)>(vb), h1 = tr_read<v_rd_off(D0, 1, 1)>(vb);
  const s16x4 l2 = tr_read<v_rd_off(D0, 2, 0)>(vb), h2 = tr_read<v_rd_off(D0, 2, 1)>(vb), l3 = tr_read<v_rd_off(D0, 3, 0)>(vb), h3 = tr_read<v_rd_off(D0, 3, 1)>(vb);
  asm volatile("s_waitcnt lgkmcnt(0)" ::: "memory"); SBAR();
#define PK(L, H) (bf16x8){L[0], L[1], L[2], L[3], H[0], H[1], H[2], H[3]}
  od = __builtin_amdgcn_mfma_f32_32x32x16_bf16(pa0, PK(l0, h0), od, 0, 0, 0);
  od = __builtin_amdgcn_mfma_f32_32x32x16_bf16(pa1, PK(l1, h1), od, 0, 0, 0);
  od = __builtin_amdgcn_mfma_f32_32x32x16_bf16(pa2, PK(l2, h2), od, 0, 0, 0);
  od = __builtin_amdgcn_mfma_f32_32x32x16_bf16(pa3, PK(l3, h3), od, 0, 0, 0);
#undef PK
}
__device__ __forceinline__ void pv_d0(f32x16* o, int vb, bf16x8 pa0, bf16x8 pa1, bf16x8 pa2, bf16x8 pa3) {
  pv_one<0>(o[0], vb, pa0, pa1, pa2, pa3); pv_one<1>(o[1], vb, pa0, pa1, pa2, pa3); pv_one<2>(o[2], vb, pa0, pa1, pa2, pa3); pv_one<3>(o[3], vb, pa0, pa1, pa2, pa3);
}

template <bool WIN>
__device__ __forceinline__ void attn_unit(const bf16* __restrict__ Qb, long ldq, const bf16* __restrict__ Kh, const bf16* __restrict__ Vh, long ldk,
                                          bf16* __restrict__ Ob, long ldo, int NT, char* lds, int e0, float slope2, float* __restrict__ lse_out, long ldl, const int tid) {
  const int wid = tid >> 6, lane = tid & 63, r32 = lane & 31, hi = lane >> 5;
  bf16* V_lds = (bf16*)lds; bf16* K_lds = (bf16*)(lds + 2 * SHM_V);
  float* ws = (float*)(lds + 2 * SHM_V + 2 * SHM_K) + wid * 64; float* li_l = ws; float* al_l = ws + 32;
  float m_reg = WIN ? -1e20f : -1e30f, l_reg = 0; f32x16 o[4] = {}; bf16x8 qr[8];
  const bf16* Qw = Qb + (long)(wid * QBLK + r32) * ldq + hi * 8;
#pragma unroll
  for (int d0 = 0; d0 < 8; ++d0) qr[d0] = *reinterpret_cast<const bf16x8*>(Qw + d0 * 16);
  const int sr = tid >> 4, sc = (tid & 15) * 8, vst0 = v_st(sr, sc), vst1 = v_st(32 + sr, sc);
  const int vb0 = (int)(uintptr_t)V_lds + v_rd_base(lane);
  float ef = (float)(e0 + 4 * hi - (wid * QBLK + r32));
  struct { bf16x8 vs0, vs1, ks0, ks1; } sr_[2];
  const unsigned voff0 = (unsigned)(sr * (int)ldk + sc) * 2u, voff1 = voff0 + (unsigned)(32 * (int)ldk) * 2u;
#define SLOAD(i, k0) do { const char* vt_ = (const char*)Vh + (size_t)(k0) * (size_t)ldk * 2; const char* kt_ = (const char*)Kh + (size_t)(k0) * (size_t)ldk * 2; \
    sr_[i].vs0 = *reinterpret_cast<const bf16x8*>(vt_ + voff0); sr_[i].vs1 = *reinterpret_cast<const bf16x8*>(vt_ + voff1); \
    sr_[i].ks0 = *reinterpret_cast<const bf16x8*>(kt_ + voff0); sr_[i].ks1 = *reinterpret_cast<const bf16x8*>(kt_ + voff1); } while (0)
#define SWRITE(b, i) do { *(bf16x8*)((char*)V_lds + (b) * SHM_V + vst0) = sr_[i].vs0;          \
    *(bf16x8*)((char*)V_lds + (b) * SHM_V + vst1) = sr_[i].vs1; int kc = sc * 2;               \
    *(bf16x8*)((char*)K_lds + (b) * SHM_K + KSWZ(sr, kc)) = sr_[i].ks0;                       \
    *(bf16x8*)((char*)K_lds + (b) * SHM_K + KSWZ(32 + sr, kc)) = sr_[i].ks1; } while (0)
#define SWAIT() do { asm volatile("s_waitcnt vmcnt(4)" ::: "memory"); } while (0)
#define RESC(a) do { if (__any((a) < 1.f)) { if (hi == 0) al_l[r32] = (a); asm volatile("s_waitcnt lgkmcnt(0)" ::: "memory"); \
    for (int d = 0; d < 4; ++d) for (int r = 0; r < 16; ++r) o[d][r] *= al_l[crow(r, hi)]; } } while (0)
#define PSM(P0, P1, MN, AL) do { if constexpr (WIN) { partialSM_win(P0, P1, m_reg, MN, AL, ef, slope2); ef += 64.f; } else partialSM(P0, P1, m_reg, MN, AL); } while (0)
  f32x16 pA0, pA1, pB0, pB1; float mnA, mnB, alA, alB; bf16x8 pa0, pa1, pa2, pa3;
  constexpr int SE = 0, SO = 1;
  SLOAD(SE, 0); asm volatile("s_waitcnt vmcnt(0)" ::: "memory"); SWRITE(0, SE); __syncthreads();
  qkt(pA0, pA1, K_lds, qr, r32, hi); PSM(pA0, pA1, mnA, alA);
  SLOAD(SO, KVBLK); if (2 < NT) SLOAD(SE, 2 * KVBLK);
  SWAIT(); SWRITE(1, SO); __syncthreads();
  for (int j = 1; j + 1 < NT; j += 2) {
    SBAR(); qkt(pB0, pB1, (bf16*)((char*)K_lds + SHM_K), qr, r32, hi);
    finishSM(pA0, pA1, alA, l_reg, pa0, pa1, pa2, pa3); SBAR();
    SLOAD(SO, (j + 2) * KVBLK); SBAR();
    pv_d0(o, vb0, pa0, pa1, pa2, pa3); PSM(pB0, pB1, mnB, alB);
    __syncthreads(); SWAIT(); SWRITE(0, SE);
    RESC(alB); __syncthreads();
    SBAR(); qkt(pA0, pA1, K_lds, qr, r32, hi);
    finishSM(pB0, pB1, alB, l_reg, pa0, pa1, pa2, pa3); SBAR();
    if (j + 3 < NT) SLOAD(SE, (j + 3) * KVBLK); SBAR();
    pv_d0(o, vb0 + (int)SHM_V, pa0, pa1, pa2, pa3); PSM(pA0, pA1, mnA, alA);
    __syncthreads(); SWAIT(); SWRITE(1, SO);
    RESC(alA); __syncthreads();
  }
  SBAR(); qkt(pB0, pB1, (bf16*)((char*)K_lds + SHM_K), qr, r32, hi);
  finishSM(pA0, pA1, alA, l_reg, pa0, pa1, pa2, pa3); SBAR();
  pv_d0(o, vb0, pa0, pa1, pa2, pa3); PSM(pB0, pB1, mnB, alB);
  __syncthreads(); RESC(alB);
  finishSM(pB0, pB1, alB, l_reg, pa0, pa1, pa2, pa3); SBAR();
  pv_d0(o, vb0 + (int)SHM_V, pa0, pa1, pa2, pa3);
  if (hi == 0) li_l[r32] = l_reg; asm volatile("s_waitcnt lgkmcnt(0)" ::: "memory");
  if constexpr (WIN) { if (hi == 0) lse_out[(long)(wid * QBLK + r32) * ldl] = (m_reg + __builtin_amdgcn_logf(l_reg)) * 0.6931471805599453f; }
  float rli[16];
#pragma unroll
  for (int r = 0; r < 16; ++r) rli[r] = __builtin_amdgcn_rcpf(li_l[crow(r, hi)]);
  bf16* Ow = Ob + (long)(wid * QBLK) * ldo;
#pragma unroll
  for (int r = 0; r < 16; ++r) { int orow = crow(r, hi);
    for (int d0 = 0; d0 < 4; ++d0) Ow[(long)orow * ldo + d0 * 32 + r32] = __float2bfloat16(o[d0][r] * rli[r]); }
#undef SLOAD
#undef SWRITE
#undef SWAIT
#undef RESC
#undef PSM
}
#undef KSWZ
#undef SBAR
}
#define LAS __attribute__((address_space(3)))
#define XB_TMO      128
#define XB_XCNT(j)  (256  + 64 * (j))
#define XB_XSUB(j)  (1280 + 64 * (j))
#define XB_XGEN(j)  (2304 + 64 * (j))
#define XB_TOP      3328
#define XB_TOPGEN   3392
#define XCD_BAR_WORDS 3456
#define XB_SPIN_CAP (1u << 18)

__device__ __forceinline__ unsigned xb_ld(unsigned* p)              { return __hip_atomic_load(p, __ATOMIC_RELAXED, __HIP_MEMORY_SCOPE_AGENT); }
__device__ __forceinline__ unsigned xb_add(unsigned* p, unsigned v) { return __hip_atomic_fetch_add(p, v, __ATOMIC_RELAXED, __HIP_MEMORY_SCOPE_AGENT); }
__device__ __forceinline__ unsigned xb_xcc_id() { return (unsigned)__builtin_amdgcn_s_getreg((3 << 11) | 20) & 0xFu; }
#define XB_SPIN(cond, bar) do { unsigned _sp = 0; while (cond) { __builtin_amdgcn_s_sleep(1); \
    if ((++_sp & 255u) == 0u) { if (xb_ld(&(bar)[XB_TMO])) break; if (_sp > XB_SPIN_CAP) { atomicAdd(&(bar)[XB_TMO], 1u); break; } } } } while (0)

struct XcdBarrier {
    unsigned* bar; unsigned x;
    volatile LAS unsigned* st;
};

__device__ __forceinline__ XcdBarrier xcd_barrier_post(unsigned* bar, volatile LAS unsigned* st, bool leader) {
    XcdBarrier b; b.bar = bar; b.x = xb_xcc_id(); b.st = st;
    if (leader) (void)xb_add(&bar[XB_XCNT(b.x)], 1u);
    return b;
}
__device__ __forceinline__ void xcd_barrier_complete(unsigned* bar, unsigned x, unsigned& nloc, unsigned& nx) {
    const unsigned G = gridDim.x * gridDim.y * gridDim.z;
    unsigned sum, cnt, mine, sp = 0u;
    for (;;) {
        sum = 0u; cnt = 0u; mine = 0u;
#pragma unroll
        for (unsigned j = 0; j < 16; ++j) { const unsigned c = xb_ld(&bar[XB_XCNT(j)]); sum += c; cnt += (c > 0u) ? 1u : 0u; mine = (j == x) ? c : mine; }
        if (sum == G) break;
        __builtin_amdgcn_s_sleep(1);
        if ((++sp & 255u) == 0u) { if (xb_ld(&bar[XB_TMO])) break; if (sp > XB_SPIN_CAP) { atomicAdd(&bar[XB_TMO], 1u); break; } }
    }
    nloc = mine > 0u ? mine : 1u; nx = cnt > 0u ? cnt : 1u;
}

__device__ __forceinline__ void xcd_barrier(const XcdBarrier& b, bool leader) {
    asm volatile("s_waitcnt vmcnt(0)" ::: "memory");
    __syncthreads();
    if (leader) {
        unsigned* bar = b.bar;
        __builtin_amdgcn_s_waitcnt(0);
        unsigned nloc = b.st[0], nx = b.st[1];
        if (nloc == 0u) { xcd_barrier_complete(bar, b.x, nloc, nx); b.st[0] = nloc; b.st[1] = nx; }
        const unsigned old = xb_add(&bar[XB_XSUB(b.x)], 1u);
        const unsigned gen = old / nloc;
        if (old + 1u == (gen + 1u) * nloc) {
            __builtin_amdgcn_fence(__ATOMIC_RELEASE, "agent");
            asm volatile("s_waitcnt vmcnt(0)" ::: "memory");
            const unsigned og = xb_add(&bar[XB_TOP], 1u);
            const unsigned tg = og / nx;
            if (og + 1u == (tg + 1u) * nx) xb_add(&bar[XB_TOPGEN], 1u);
            else XB_SPIN(xb_ld(&bar[XB_TOPGEN]) == tg, bar);
            __builtin_amdgcn_fence(__ATOMIC_ACQUIRE, "agent");
            xb_add(&bar[XB_XGEN(b.x)], 1u);
            asm volatile("s_waitcnt vmcnt(0)" ::: "memory");
        } else {
            XB_SPIN(xb_ld(&bar[XB_XGEN(b.x)]) == gen, bar);
            __builtin_amdgcn_fence(__ATOMIC_ACQUIRE, "agent");
            asm volatile("s_waitcnt vmcnt(0)" ::: "memory");
        }
    }
    __syncthreads();
}

typedef unsigned short bf16u;
typedef unsigned v4u __attribute__((ext_vector_type(4)));
typedef unsigned v2u __attribute__((ext_vector_type(2)));
typedef float f32x4 __attribute__((ext_vector_type(4)));

constexpr int M = 16384, DM = 2048, SEQ = 4096, NIN = 10240, NQKV = 6144, NGATE = 4096, FF = 5632;
constexpr float ALPHA = 1.189207115002721f;
constexpr float RMS_EPS = 1e-6f, LN_EPS = 1e-5f;
constexpr float W8_SCALE = 64.f;
constexpr int NTHR = 512, NWAVES = 8;
constexpr int LDS_BYTES = 131072 + 2048;

constexpr size_t MiB = 1u << 20;
constexpr size_t WS_WGU = 1 * MiB, WS_WDN = 45 * MiB, WS_WOUT = 67 * MiB, WS_WPA = 75 * MiB, WS_WPB = 79 * MiB;
constexpr size_t WS_WIN = 81 * MiB, WS_XB = 121 * MiB, WS_QKV = 185 * MiB, WS_G = 377 * MiB, WS_END = 505 * MiB;
constexpr size_t WS_OA = 81 * MiB, WS_OBP = 113 * MiB, WS_LSE = 161 * MiB, WS_OB = 162 * MiB;
constexpr size_t WS_MP = 185 * MiB, WS_X1B = 249 * MiB, WS_H = 313 * MiB;

struct Params {
    const float *x, *w_in, *b_gate, *qn, *kn, *wpa, *wpb, *wout, *ln1g, *ln1b, *wg, *wu, *wd, *ln2g, *ln2b;
    float* out; unsigned char* ws;
};

__device__ __forceinline__ unsigned f2bf(float f) { unsigned u = __builtin_bit_cast(unsigned, f); return (u + 0x7fffu + ((u >> 16) & 1u)) >> 16; }
__device__ __forceinline__ unsigned pk2(float lo, float hi) { return f2bf(lo) | (f2bf(hi) << 16); }
__device__ __forceinline__ float bf2f(unsigned short h) { return __uint_as_float((unsigned)h << 16); }
__device__ __forceinline__ float wave_sum(float v) {
#pragma unroll
    for (int o = 1; o < 64; o <<= 1) v += __shfl_xor(v, o);
    return v;
}

__device__ __forceinline__ void transpose_item(const float* W, int K, int N, bf16u* WT, int k0, int n0, int drow0, LAS float* scr, int lane) {
#pragma unroll 8
    for (int i = 0; i < 32; ++i) { const int kk = 2 * i + (lane >> 5); scr[kk * 33 + (lane & 31)] = W[(size_t)(k0 + kk) * N + n0 + (lane & 31)]; }
    asm volatile("s_waitcnt lgkmcnt(0)" ::: "memory");
    const int c = lane & 7;
#pragma unroll
    for (int j = 0; j < 4; ++j) { const int n = (lane >> 3) + 8 * j; const LAS float* s = scr + (8 * c) * 33 + n;
        v4u o; o.x = pk2(s[0 * 33], s[1 * 33]); o.y = pk2(s[2 * 33], s[3 * 33]); o.z = pk2(s[4 * 33], s[5 * 33]); o.w = pk2(s[6 * 33], s[7 * 33]);
        *(v4u*)(WT + (size_t)(drow0 + n) * K + k0 + 8 * c) = o; }
    asm volatile("s_waitcnt lgkmcnt(0)" ::: "memory");
}

__device__ __forceinline__ unsigned pk4_fp8(float a, float b, float c, float d) {
    int w = __builtin_amdgcn_cvt_pk_fp8_f32(a, b, 0, false); w = __builtin_amdgcn_cvt_pk_fp8_f32(c, d, w, true); return (unsigned)w; }
__device__ __forceinline__ void transpose_item8(const float* W, int K, int N, unsigned char* WT, int k0, int n0, int drow0, LAS float* scr, int lane, float scale) {
#pragma unroll 8
    for (int i = 0; i < 32; ++i) { const int kk = 2 * i + (lane >> 5); scr[kk * 33 + (lane & 31)] = W[(size_t)(k0 + kk) * N + n0 + (lane & 31)]; }
    asm volatile("s_waitcnt lgkmcnt(0)" ::: "memory");
    const int c = lane & 3;
#pragma unroll
    for (int j = 0; j < 2; ++j) { const int n = (lane >> 2) + 16 * j; const LAS float* s = scr + (16 * c) * 33 + n;
        v4u o;
        o.x = pk4_fp8(s[0 * 33] * scale, s[1 * 33] * scale, s[2 * 33] * scale, s[3 * 33] * scale);
        o.y = pk4_fp8(s[4 * 33] * scale, s[5 * 33] * scale, s[6 * 33] * scale, s[7 * 33] * scale);
        o.z = pk4_fp8(s[8 * 33] * scale, s[9 * 33] * scale, s[10 * 33] * scale, s[11 * 33] * scale);
        o.w = pk4_fp8(s[12 * 33] * scale, s[13 * 33] * scale, s[14 * 33] * scale, s[15 * 33] * scale);
        *(v4u*)(WT + (size_t)(drow0 + n) * K + k0 + 16 * c) = o; }
    asm volatile("s_waitcnt lgkmcnt(0)" ::: "memory");
}

__device__ __forceinline__ void ln_row(const float* src, const float* g, const float* b, float* dst, bf16u* dstb, int lane) {
    const f32x4* xr = (const f32x4*)src + lane;
    f32x4 v[8]; float s = 0.f;
#pragma unroll
    for (int j = 0; j < 8; ++j) { v[j] = xr[64 * j]; s += (v[j].x + v[j].y) + (v[j].z + v[j].w); }
    const float mean = wave_sum(s) * (1.f / DM); float s2 = 0.f;
#pragma unroll
    for (int j = 0; j < 8; ++j) { v[j] = v[j] - mean; s2 += (v[j].x * v[j].x + v[j].y * v[j].y) + (v[j].z * v[j].z + v[j].w * v[j].w); }
    const float rstd = 1.f / sqrtf(wave_sum(s2) * (1.f / DM) + LN_EPS);
    f32x4* o4 = (f32x4*)dst + lane;
#pragma unroll
    for (int j = 0; j < 8; ++j) { const f32x4 gg = ((const f32x4*)g)[64 * j + lane], bb = ((const f32x4*)b)[64 * j + lane];
        const f32x4 y = v[j] * rstd * gg + bb; o4[64 * j] = y;
        if (dstb) { v2u w; w.x = pk2(y.x, y.y); w.y = pk2(y.z, y.w); ((v2u*)dstb)[64 * j + lane] = w; } }
}

#ifndef REP_P1
#define REP_P1 1
#endif
#ifndef REP_P7
#define REP_P7 1
#endif
#ifndef REP_P0
#define REP_P0 1
#endif
#ifndef REP_A
#define REP_A 1
#endif
#ifndef REP_B
#define REP_B 1
#endif
#ifndef REP_SYNC
#define REP_SYNC 0
#endif
#ifndef REP_LN
#define REP_LN 1
#endif
__global__ void __launch_bounds__(NTHR, 2) mega_fwd(Params p) {
    extern __shared__ __attribute__((aligned(16))) unsigned char lds[];
    cg::grid_group grid = cg::this_grid();
    const int wave = __builtin_amdgcn_readfirstlane((int)threadIdx.x >> 6);
#define FRESH_LANE(L) int L; asm volatile("v_mbcnt_lo_u32_b32 %0, -1, 0\n\tv_mbcnt_hi_u32_b32 %0, -1, %0" : "=v"(L))
    const int G = gridDim.x, bx = blockIdx.x;
    const int vcu = (G % 8 == 0) ? (bx % 8) * (G / 8) + bx / 8 : bx;
    const int gw = vcu * NWAVES + wave, NGW = G * NWAVES;
    unsigned char* ws = p.ws;
    bf16u* WGU = (bf16u*)(ws + WS_WGU); bf16u* WDN = (bf16u*)(ws + WS_WDN); bf16u* WOUT = (bf16u*)(ws + WS_WOUT);
    bf16u* WPA = (bf16u*)(ws + WS_WPA); bf16u* WPB = (bf16u*)(ws + WS_WPB); bf16u* WINT = (bf16u*)(ws + WS_WIN);
    bf16u* XB = (bf16u*)(ws + WS_XB); bf16u* QKV = (bf16u*)(ws + WS_QKV); bf16u* GB = (bf16u*)(ws + WS_G);
    bf16u* OA = (bf16u*)(ws + WS_OA); bf16u* OBP = (bf16u*)(ws + WS_OBP); float* LSE = (float*)(ws + WS_LSE); bf16u* OB = (bf16u*)(ws + WS_OB);
    bf16u* MP = (bf16u*)(ws + WS_MP); bf16u* X1B = (bf16u*)(ws + WS_X1B); bf16u* HB = (bf16u*)(ws + WS_H);
    LAS unsigned char* ldsl = (LAS unsigned char*)lds;
    unsigned* barw = (unsigned*)ws;
    volatile LAS unsigned* MISC = (volatile LAS unsigned*)(ldsl + 131072 + 1024);
    { FRESH_LANE(l0); if (wave == 0 && l0 < 2) MISC[l0] = 0u; if (bx == 0) for (int i = wave * 64 + l0; i < XCD_BAR_WORDS; i += NTHR) __hip_atomic_store(barw + i, 0u, __ATOMIC_RELAXED, __HIP_MEMORY_SCOPE_AGENT); }
#define SEAM() do { FRESH_LANE(ls_); xcd_barrier(xbar, wave == 0 && ls_ == 0); } while (0)

    for (int rep_ = 0; rep_ < REP_P0; ++rep_) {
        FRESH_LANE(lane); const int tid = wave * 64 + lane;
        LAS float* scr = (LAS float*)(ldsl + wave * 8704);
        constexpr int I_IN = 32 * 320, I_G = 32 * 176, I_U = I_G, I_D = 88 * 64, I_O = 32 * 64, I_PA = 16 * 64, I_PB = 8 * 64;
        constexpr int NITEMS = I_IN + I_G + I_U + I_D + I_O + I_PA + I_PB;
        for (int it = gw; it < NITEMS; it += NGW) {
            int r = it;
            if (r < I_IN) { const int kb = r / 320, nb = r % 320; transpose_item8(p.w_in, 2048, NIN, (unsigned char*)WINT, 64 * kb, 32 * nb, 32 * nb, scr, lane, W8_SCALE); continue; } r -= I_IN;
            if (r < I_G) { const int kb = r / 176, nb = r % 176, n0 = 32 * nb; transpose_item(p.wg, 2048, FF, WGU, 64 * kb, n0, 256 * (n0 >> 7) + (n0 & 127), scr, lane); continue; } r -= I_G;
            if (r < I_U) { const int kb = r / 176, nb = r % 176, n0 = 32 * nb; transpose_item(p.wu, 2048, FF, WGU, 64 * kb, n0, 256 * (n0 >> 7) + 128 + (n0 & 127), scr, lane); continue; } r -= I_U;
            if (r < I_D) { const int kb = r / 64, nb = r % 64; transpose_item(p.wd, FF, 2048, WDN, 64 * kb, 32 * nb, 32 * nb, scr, lane); continue; } r -= I_D;
            if (r < I_O) { const int kb = r / 64, nb = r % 64; transpose_item(p.wout, 2048, 2048, WOUT, 64 * kb, 32 * nb, 32 * nb, scr, lane); continue; } r -= I_O;
            if (r < I_PA) { const int kb = r / 64, nb = r % 64; transpose_item(p.wpa, 1024, 2048, WPA, 64 * kb, 32 * nb, 32 * nb, scr, lane); continue; } r -= I_PA;
            { const int kb = r / 64, nb = r % 64; transpose_item(p.wpb, 512, 2048, WPB, 64 * kb, 32 * nb, 32 * nb, scr, lane); }
        }
        const size_t n16 = (size_t)M * DM / 16;
        for (size_t i = (size_t)bx * NTHR + tid; i < n16; i += (size_t)G * NTHR) {
            const f32x4 a = ((const f32x4*)p.x)[4 * i], b = ((const f32x4*)p.x)[4 * i + 1], c = ((const f32x4*)p.x)[4 * i + 2], d = ((const f32x4*)p.x)[4 * i + 3];
            v4u o; o.x = pk4_fp8(a.x, a.y, a.z, a.w); o.y = pk4_fp8(b.x, b.y, b.z, b.w); o.z = pk4_fp8(c.x, c.y, c.z, c.w); o.w = pk4_fp8(d.x, d.y, d.z, d.w);
            ((v4u*)XB)[i] = o;
        }
    }
    grid.sync();
    XcdBarrier xbar; { FRESH_LANE(l1); xbar = xcd_barrier_post(barw, MISC, wave == 0 && l1 == 0); }

    for (int rep_ = 0; rep_ < REP_P1; ++rep_) {
        pg8::Gemm g{XB, WINT, M, NIN, DM}; pg8::StaticOrder S; S.init(M, NIN, G, bx);
        pg8::EpiQKVG E{QKV, GB, p.b_gate, 1.f / W8_SCALE};
        FRESH_LANE(lane); pg8::gemm_phase<pg8::EpiQKVG, pg8::StaticOrder, true, PG8_SP2, true>(ldsl, g, S, E, wave * 64 + lane);
    }
    SEAM();

    {
        FRESH_LANE(lane);
        const int i = lane & 31, h2 = lane >> 5;
        const float freq = __builtin_amdgcn_exp2f(-(float)i * (13.287712379549449f / 32.f));
        const float gq0 = p.qn[i], gq1 = p.qn[i + 32], gq2 = p.qn[i + 64], gq3 = p.qn[i + 96];
        const float gk0 = p.kn[i], gk1 = p.kn[i + 32], gk2 = p.kn[i + 64], gk3 = p.kn[i + 96];
        for (int t = gw; t < M; t += NGW) {
            const int pos = t & (SEQ - 1), rid = pos >> 6, cid = pos & 63;
            float ar = (float)rid * freq * 0.15915494309189535f, ac = (float)cid * freq * 0.15915494309189535f;
            ar -= floorf(ar); ac -= floorf(ac);
            const float sr = __builtin_amdgcn_sinf(ar), cr = __builtin_amdgcn_cosf(ar), sc = __builtin_amdgcn_sinf(ac), cc = __builtin_amdgcn_cosf(ac);
#pragma unroll
            for (int it = 0; it < 5; ++it) {
                const int head = 2 * it + h2; bf16u* hp = QKV + (size_t)t * NQKV + head * 128;
                float a = bf2f(hp[i]), b = bf2f(hp[i + 32]), c = bf2f(hp[i + 64]), d = bf2f(hp[i + 96]);
                float ss = (a * a + b * b) + (c * c + d * d);
#pragma unroll
                for (int o = 1; o < 32; o <<= 1) ss += __shfl_xor(ss, o);
                const float rs = 1.f / sqrtf(ss * (1.f / 128.f) + RMS_EPS);
                const bool isq = head < 8;
                a *= rs * (isq ? gq0 : gk0); b *= rs * (isq ? gq1 : gk1); c *= rs * (isq ? gq2 : gk2); d *= rs * (isq ? gq3 : gk3);
                hp[i] = (bf16u)f2bf(a * cr - b * sr); hp[i + 32] = (bf16u)f2bf(b * cr + a * sr);
                hp[i + 64] = (bf16u)f2bf(c * cc - d * sc); hp[i + 96] = (bf16u)f2bf(d * cc + c * sc);
            }
        }
    }
    SEAM();

    {
        FRESH_LANE(lane); const int tid = wave * 64 + lane;
        const att::bf16* Q = (const att::bf16*)QKV;
        for (int rep_ = 0; rep_ < REP_A; ++rep_)
        for (int u = vcu; u < 512; u += G) {
            const int bk = u >> 6, b = bk >> 1, kvh = bk & 1, rem = u & 63, hq = kvh * 4 + (rem >> 4), qblk = rem & 15;
            const size_t row0 = (size_t)b * SEQ;
            att::attn_unit<false>(Q + (row0 + qblk * 256) * NQKV + hq * 128, NQKV, Q + row0 * NQKV + 1024 + kvh * 128, Q + row0 * NQKV + 1280 + kvh * 128, NQKV,
                                  (att::bf16*)OA + (row0 + qblk * 256) * 1024 + hq * 128, 1024, SEQ / 64, (char*)lds, 0, 0.f, nullptr, 0, tid);
        }
        FRESH_LANE(laneb); const int tidb = wave * 64 + laneb;
        for (int rep_ = 0; rep_ < REP_B; ++rep_)
        for (int u = vcu; u < 768; u += G) {
            const int g = u >> 8, idx = u & 255, b = idx >> 6, h = (idx >> 4) & 3, sub = idx & 15;
            const int dil = g == 0 ? 1 : (g == 1 ? 4 : 16), lsub = SEQ / dil;
            const int c = g == 0 ? 0 : (g == 1 ? (sub >> 2) : sub), qblk = g == 0 ? sub : (g == 1 ? (sub & 3) : 0);
            const int q0 = qblk * 256, NT = g == 2 ? 4 : 6;
            int kv0 = q0 - 64; if (kv0 > lsub - 64 * NT) kv0 = lsub - 64 * NT; if (kv0 < 0) kv0 = 0;
            const int gh = g * 4 + h;
            const float slope2 = __builtin_amdgcn_exp2f(-8.f * (float)(gh + 1) / 12.f) * (float)dil * 1.4426950408889634f;
            const size_t row0 = (size_t)b * SEQ + c;
            att::attn_unit<true>(Q + (row0 + (size_t)dil * q0) * NQKV + 1536 + gh * 128, (long)dil * NQKV,
                                 Q + (row0 + (size_t)dil * kv0) * NQKV + 3072 + gh * 128, Q + (row0 + (size_t)dil * kv0) * NQKV + 4608 + gh * 128, (long)dil * NQKV,
                                 (att::bf16*)OBP + (size_t)g * M * 512 + (row0 + (size_t)dil * q0) * 512 + h * 128, (long)dil * 512, NT, (char*)lds, kv0 - q0, slope2,
                                 LSE + (size_t)g * M * 4 + (row0 + (size_t)dil * q0) * 4 + h, (long)dil * 4, tidb);
        }
    }
    SEAM();

    {
        FRESH_LANE(lane);
        for (int t = gw; t < M; t += NGW) {
            const int h = lane >> 4;
            const float l0 = LSE[(size_t)t * 4 + h], l1 = LSE[(size_t)M * 4 + (size_t)t * 4 + h], l2 = LSE[(size_t)2 * M * 4 + (size_t)t * 4 + h];
            const float mx = fmaxf(l0, fmaxf(l1, l2));
            float w0 = __expf(l0 - mx), w1 = __expf(l1 - mx), w2 = __expf(l2 - mx); const float inv = 1.f / (w0 + w1 + w2); w0 *= inv; w1 *= inv; w2 *= inv;
            const v4u a = ((const v4u*)(OBP + (size_t)t * 512))[lane], b = ((const v4u*)(OBP + (size_t)M * 512 + (size_t)t * 512))[lane], c = ((const v4u*)(OBP + (size_t)2 * M * 512 + (size_t)t * 512))[lane];
            v4u o;
#pragma unroll
            for (int e = 0; e < 4; ++e) {
                const float lo = w0 * __uint_as_float(a[e] << 16) + w1 * __uint_as_float(b[e] << 16) + w2 * __uint_as_float(c[e] << 16);
                const float hi = w0 * __uint_as_float(a[e] & 0xffff0000u) + w1 * __uint_as_float(b[e] & 0xffff0000u) + w2 * __uint_as_float(c[e] & 0xffff0000u);
                o[e] = pk2(lo, hi); }
            ((v4u*)(OB + (size_t)t * 512))[lane] = o;
        }
        pg8::Gemm g{OA, WPA, M, DM, 1024}; pg8::StaticOrder S; S.init(M, DM, G, bx);
        pg8::EpiGateA E{p.out, GB};
        FRESH_LANE(lane2); pg8::gemm_phase<pg8::EpiGateA, pg8::StaticOrder, true, PG8_SP2>(ldsl, g, S, E, wave * 64 + lane2);
    }
    SEAM();

    {
        pg8::Gemm g{OB, WPB, M, DM, 512}; pg8::StaticOrder S; S.init(M, DM, G, bx);
        pg8::EpiGateB E{p.out, GB, MP};
        FRESH_LANE(lane2); pg8::gemm_phase<pg8::EpiGateB, pg8::StaticOrder, true, PG8_SP2>(ldsl, g, S, E, wave * 64 + lane2);
    }
    SEAM();

    {
        pg8::Gemm g{MP, WOUT, M, DM, DM}; pg8::StaticOrder S; S.init(M, DM, G, bx);
        pg8::EpiResid E{p.x, p.out, ALPHA};
        FRESH_LANE(lane2); pg8::gemm_phase<pg8::EpiResid, pg8::StaticOrder, true, PG8_SP2>(ldsl, g, S, E, wave * 64 + lane2);
    }
    SEAM();

    for (int rep_ = 0; rep_ < REP_SYNC; ++rep_) SEAM();
    for (int rep_ = 1; rep_ < REP_LN; ++rep_) { FRESH_LANE(lane); for (int t = gw; t < M; t += NGW) ln_row(p.out + (size_t)t * DM, p.ln1g, p.ln1b, (float*)(ws + WS_H) + (size_t)t * DM, X1B + (size_t)t * DM, lane); }
    { FRESH_LANE(lane); for (int t = gw; t < M; t += NGW) ln_row(p.out + (size_t)t * DM, p.ln1g, p.ln1b, p.out + (size_t)t * DM, X1B + (size_t)t * DM, lane); }
    SEAM();

    for (int rep_ = 0; rep_ < REP_P7; ++rep_) {
        pg8::Gemm g{X1B, WGU, M, 2 * FF, DM}; pg8::StaticOrder S; S.init(M, 2 * FF, G, bx);
        pg8::EpiSwiGLU E{HB};
        FRESH_LANE(lane2); pg8::gemm_phase<pg8::EpiSwiGLU, pg8::StaticOrder, true, PG8_SP2>(ldsl, g, S, E, wave * 64 + lane2);
    }
    SEAM();

    {
        pg8::Gemm g{HB, WDN, M, DM, FF}; pg8::StaticOrder S; S.init(M, DM, G, bx);
        pg8::EpiResid E{p.out, p.out, ALPHA};
        FRESH_LANE(lane2); pg8::gemm_phase<pg8::EpiResid, pg8::StaticOrder, true, PG8_SP2>(ldsl, g, S, E, wave * 64 + lane2);
    }
    SEAM();

    { FRESH_LANE(lane); for (int t = gw; t < M; t += NGW) ln_row(p.out + (size_t)t * DM, p.ln2g, p.ln2b, p.out + (size_t)t * DM, nullptr, lane); }
}

extern "C" void kernel_launch(void* const* d_in, const int* in_sizes, int n_in, void* d_out, int out_size, void* d_ws, size_t ws_size, hipStream_t stream) {
    static int grid = 0;
    if (grid == 0) {
        if (n_in != 15 || in_sizes[0] != M * DM || out_size != M * DM || ws_size < WS_END) {
            fprintf(stderr, "kernel_launch: shape mismatch n_in %d in0 %d out %d ws %zu (need %zu)\n", n_in, n_in > 0 ? in_sizes[0] : -1, out_size, ws_size, (size_t)WS_END); grid = -1; return; }
        int dev = 0, cus = 0, per_cu = 0;
        hipGetDevice(&dev); hipDeviceGetAttribute(&cus, hipDeviceAttributeMultiprocessorCount, dev);
        if (hipFuncSetAttribute((const void*)mega_fwd, hipFuncAttributeMaxDynamicSharedMemorySize, LDS_BYTES) != hipSuccess) { fprintf(stderr, "kernel_launch: hipFuncSetAttribute failed\n"); grid = -1; return; }
        if (hipOccupancyMaxActiveBlocksPerMultiprocessor(&per_cu, (const void*)mega_fwd, NTHR, LDS_BYTES) != hipSuccess || per_cu < 1) { fprintf(stderr, "kernel_launch: occupancy query gave %d\n", per_cu); per_cu = 1; }
        (void)hipGetLastError();
        grid = cus * per_cu;
    }
    if (grid < 0) return;
    Params p{};
    p.x = (const float*)d_in[0]; p.w_in = (const float*)d_in[1]; p.b_gate = (const float*)d_in[2]; p.qn = (const float*)d_in[3]; p.kn = (const float*)d_in[4];
    p.wpa = (const float*)d_in[5]; p.wpb = (const float*)d_in[6]; p.wout = (const float*)d_in[7]; p.ln1g = (const float*)d_in[8]; p.ln1b = (const float*)d_in[9];
    p.wg = (const float*)d_in[10]; p.wu = (const float*)d_in[11]; p.wd = (const float*)d_in[12]; p.ln2g = (const float*)d_in[13]; p.ln2b = (const float*)d_in[14];
    p.out = (float*)d_out; p.ws = (unsigned char*)d_ws;
    void* args[] = {&p};
    hipError_t e = hipLaunchCooperativeKernel((const void*)mega_fwd, dim3(grid), dim3(NTHR), args, LDS_BYTES, stream);
    if (e != hipSuccess) fprintf(stderr, "kernel_launch: cooperative launch failed: %s (grid %d)\n", hipGetErrorString(e), grid);
}
```

```cpp
#include <hip/hip_runtime.h>
#include <hip/hip_bf16.h>
#include <hip/hip_cooperative_groups.h>
#include <cstdio>
#include <cstdint>
#include <cmath>
namespace cg = cooperative_groups;
namespace pg8 {
#define PG8_LAS __attribute__((address_space(3)))
typedef unsigned short bf16_t;
typedef short bf16x8 __attribute__((ext_vector_type(8)));
typedef float f32x4 __attribute__((ext_vector_type(4)));
typedef unsigned u32x4 __attribute__((ext_vector_type(4)));
typedef int i32x4 __attribute__((ext_vector_type(4)));
typedef int i32x8 __attribute__((ext_vector_type(8)));
constexpr int BM = 256, BK = 64, HALF = 128, HTB = HALF * BK * 2  , STAGE_BYTES = 8 * HTB, NXCD = 8, WGM = 8;

__host__ __device__ __forceinline__ int lds_byte(int r, int c) { const int st = (r >> 4) * 2 + (c >> 5), rr = r & 15, cc = c & 31, ob = rr * 64 + cc * 2; return st * 1024 + (ob ^ (((ob >> 9) & 1) << 5)); }
__host__ __device__ __forceinline__ void stage_rc(int b, int& R, int& C) { const int st = b / 1024, sb = b % 1024, swz = sb ^ (((sb >> 9) & 1) << 5); R = (st >> 1) * 16 + swz / 64; C = (st & 1) * 32 + (swz % 64) / 2; }
__host__ __device__ __forceinline__ int perm32(int rho) { const int n = rho >> 4, i = rho & 15; return 8 * (i >> 2) + 4 * n + (i & 3); }

struct Unit { int pm, pn; };
struct Gemm { const bf16_t* A; const bf16_t* Bt; int M, N, K; };

struct StaticOrder {
    int nM, nN, nwg, G, c;
    __host__ __device__ void init(int M, int N, int G_, int c_) { nM = M / BM; nN = N / BM; nwg = nM * nN; G = G_; c = c_; }
    __host__ __device__ bool next(int i, Unit& u) const {
        const long L = (long)i * G + c; if (L >= nwg) return false;
        int wgid = (int)L; { const int q = nwg / NXCD, r = nwg % NXCD, xcd = wgid % NXCD, off = wgid / NXCD; wgid = (xcd < r ? xcd * (q + 1) : r * (q + 1) + (xcd - r) * q) + off; }
        const int nig = WGM * nN, gid = wgid / nig, fm = gid * WGM, gsz = (nM - fm) < WGM ? (nM - fm) : WGM;
        u.pm = fm + ((wgid % nig) % gsz); u.pn = (wgid % nig) / gsz; return true;
    }
    __device__ __forceinline__ void a_ready(const Unit&) const {}
    __device__ __forceinline__ void done(const Unit&) const {}
};

typedef float f32x2_t __attribute__((ext_vector_type(2))); typedef __bf16 bf16x2_t __attribute__((ext_vector_type(2)));
__device__ __forceinline__ unsigned cvt_pk_bf16(float lo, float hi) { f32x2_t v = {lo, hi}; bf16x2_t b = __builtin_convertvector(v, bf16x2_t); return __builtin_bit_cast(unsigned, b); }
typedef float f32x2 __attribute__((ext_vector_type(2)));
typedef unsigned u32x2 __attribute__((ext_vector_type(2)));
__device__ __forceinline__ float sigmoid_f(float x) { return __builtin_amdgcn_rcpf(1.0f + __builtin_amdgcn_exp2f(-1.4426950408889634f * x)); }
__device__ __forceinline__ float bf_lo(unsigned w) { return __uint_as_float(w << 16); }
__device__ __forceinline__ float bf_hi(unsigned w) { return __uint_as_float(w & 0xffff0000u); }
__device__ __forceinline__ unsigned pk4_fp8(float a, float b, float c, float d) {
    int w = __builtin_amdgcn_cvt_pk_fp8_f32(a, b, 0, false); w = __builtin_amdgcn_cvt_pk_fp8_f32(c, d, w, true); return (unsigned)w; }

struct EpiQKVG {
    static constexpr bool PERM = true, AFTER_DRAIN = false;
    bf16_t* QKV; bf16_t* G; const float* bgate; float sc;
    __device__ __forceinline__ void operator()(const f32x4 (&acc)[2][2][4][2], const Unit& u, int wr, int wc, int fr, int fq) const {
        const int row0 = u.pm * BM + wr * 64 + fr;
        if (u.pn < 24) {
            const int col0 = u.pn * BM + wc * 32 + 8 * fq;
#pragma unroll
            for (int ai = 0; ai < 2; ++ai)
#pragma unroll
                for (int m = 0; m < 4; ++m) { bf16_t* rowp = QKV + (size_t)(row0 + ai * HALF + m * 16) * 6144 + col0;
#pragma unroll
                    for (int bj = 0; bj < 2; ++bj) { const f32x4 v0 = acc[ai][bj][m][0] * sc, v1 = acc[ai][bj][m][1] * sc;
                        u32x4 w; w.x = cvt_pk_bf16(v0[0], v0[1]); w.y = cvt_pk_bf16(v0[2], v0[3]); w.z = cvt_pk_bf16(v1[0], v1[1]); w.w = cvt_pk_bf16(v1[2], v1[3]);
                        *(u32x4*)(rowp + bj * HALF) = w; } }
        } else {
            const int col0 = (u.pn - 24) * BM + wc * 32 + 8 * fq;
            f32x4 bv[2][2];
#pragma unroll
            for (int bj = 0; bj < 2; ++bj)
#pragma unroll
                for (int n = 0; n < 2; ++n) bv[bj][n] = *(const f32x4*)(bgate + col0 + bj * HALF + 4 * n);
#pragma unroll
            for (int ai = 0; ai < 2; ++ai)
#pragma unroll
                for (int m = 0; m < 4; ++m) { bf16_t* rowp = G + (size_t)(row0 + ai * HALF + m * 16) * 4096 + col0;
#pragma unroll
                    for (int bj = 0; bj < 2; ++bj) { f32x4 v0 = acc[ai][bj][m][0] * sc + bv[bj][0], v1 = acc[ai][bj][m][1] * sc + bv[bj][1];
#pragma unroll
                        for (int e = 0; e < 4; ++e) { v0[e] = sigmoid_f(v0[e]); v1[e] = sigmoid_f(v1[e]); }
                        u32x4 w; w.x = cvt_pk_bf16(v0[0], v0[1]); w.y = cvt_pk_bf16(v0[2], v0[3]); w.z = cvt_pk_bf16(v1[0], v1[1]); w.w = cvt_pk_bf16(v1[2], v1[3]);
                        *(u32x4*)(rowp + bj * HALF) = w; } }
        }
    }
};

struct EpiGateA {
    static constexpr bool PERM = false, AFTER_DRAIN = false;
    float* T; const bf16_t* G; float sc;
    __device__ __forceinline__ void operator()(const f32x4 (&acc)[2][2][4][2], const Unit& u, int wr, int wc, int fr, int fq) const {
        const int row0 = u.pm * BM + wr * 64 + fr, col0 = u.pn * BM + wc * 32 + 4 * fq;
#pragma unroll
        for (int ai = 0; ai < 2; ++ai)
#pragma unroll
            for (int m = 0; m < 4; ++m) { const size_t r = (size_t)(row0 + ai * HALF + m * 16);
#pragma unroll
                for (int bj = 0; bj < 2; ++bj)
#pragma unroll
                    for (int n = 0; n < 2; ++n) { const int c = col0 + bj * HALF + n * 16;
                        const u32x2 g = *(const u32x2*)(G + r * 4096 + c); const f32x4 a = acc[ai][bj][m][n];
                        f32x4 o; o[0] = a[0] * bf_lo(g.x); o[1] = a[1] * bf_hi(g.x); o[2] = a[2] * bf_lo(g.y); o[3] = a[3] * bf_hi(g.y);
                        *(f32x4*)(T + r * 2048 + c) = o * sc; }
                if (m & 1) asm volatile("" ::: "memory"); }
    }
};

struct EpiGateB {
    static constexpr bool PERM = true, AFTER_DRAIN = false;
    const float* T; const bf16_t* G; unsigned char* MP; float sc, so;
    __device__ __forceinline__ void operator()(const f32x4 (&acc)[2][2][4][2], const Unit& u, int wr, int wc, int fr, int fq) const {
        const int row0 = u.pm * BM + wr * 64 + fr, col0 = u.pn * BM + wc * 32 + 8 * fq;
#pragma unroll
        for (int ai = 0; ai < 2; ++ai)
#pragma unroll
            for (int m = 0; m < 4; ++m) { const size_t r = (size_t)(row0 + ai * HALF + m * 16);
#pragma unroll
                for (int bj = 0; bj < 2; ++bj) { const int c = col0 + bj * HALF;
                    const u32x4 g = *(const u32x4*)(G + r * 4096 + 2048 + c);
                    const f32x4 t0 = *(const f32x4*)(T + r * 2048 + c), t1 = *(const f32x4*)(T + r * 2048 + c + 4);
                    const f32x4 a0 = acc[ai][bj][m][0], a1 = acc[ai][bj][m][1];
                    const f32x4 a0s = a0 * sc, a1s = a1 * sc;
                    u32x2 w;
                    w.x = pk4_fp8((t0[0] + a0s[0] * bf_lo(g.x)) * so, (t0[1] + a0s[1] * bf_hi(g.x)) * so, (t0[2] + a0s[2] * bf_lo(g.y)) * so, (t0[3] + a0s[3] * bf_hi(g.y)) * so);
                    w.y = pk4_fp8((t1[0] + a1s[0] * bf_lo(g.z)) * so, (t1[1] + a1s[1] * bf_hi(g.z)) * so, (t1[2] + a1s[2] * bf_lo(g.w)) * so, (t1[3] + a1s[3] * bf_hi(g.w)) * so);
                    *(u32x2*)(MP + r * 2048 + c) = w; }
                if (m & 1) asm volatile("" ::: "memory"); }
    }
};

struct EpiResid {
    static constexpr bool PERM = false, AFTER_DRAIN = false;
    const float* base; float* out; float alpha, sc;
    __device__ __forceinline__ void operator()(const f32x4 (&acc)[2][2][4][2], const Unit& u, int wr, int wc, int fr, int fq) const {
        const int row0 = u.pm * BM + wr * 64 + fr, col0 = u.pn * BM + wc * 32 + 4 * fq;
#pragma unroll
        for (int ai = 0; ai < 2; ++ai)
#pragma unroll
            for (int m = 0; m < 4; ++m) { const size_t r = (size_t)(row0 + ai * HALF + m * 16);
#pragma unroll
                for (int bj = 0; bj < 2; ++bj)
#pragma unroll
                    for (int n = 0; n < 2; ++n) { const int c = col0 + bj * HALF + n * 16;
                        const f32x4 b = *(const f32x4*)(base + r * 2048 + c);
                        *(f32x4*)(out + r * 2048 + c) = b * alpha + acc[ai][bj][m][n] * sc; }
                if (m & 1) asm volatile("" ::: "memory"); }
    }
};

struct EpiSwiGLU {
    static constexpr bool PERM = true, AFTER_DRAIN = false;
    bf16_t* H;
    __device__ __forceinline__ void operator()(const f32x4 (&acc)[2][2][4][2], const Unit& u, int wr, int wc, int fr, int fq) const {
        const int row0 = u.pm * BM + wr * 64 + fr, col0 = u.pn * HALF + wc * 32 + 8 * fq;
#pragma unroll
        for (int ai = 0; ai < 2; ++ai)
#pragma unroll
            for (int m = 0; m < 4; ++m) { bf16_t* rowp = H + (size_t)(row0 + ai * HALF + m * 16) * 5632 + col0;
                f32x4 h0, h1;
#pragma unroll
                for (int e = 0; e < 4; ++e) { const float g0 = acc[ai][0][m][0][e], g1 = acc[ai][0][m][1][e];
                    h0[e] = g0 * sigmoid_f(g0) * acc[ai][1][m][0][e]; h1[e] = g1 * sigmoid_f(g1) * acc[ai][1][m][1][e]; }
                u32x4 w; w.x = cvt_pk_bf16(h0[0], h0[1]); w.y = cvt_pk_bf16(h0[2], h0[3]); w.z = cvt_pk_bf16(h1[0], h1[1]); w.w = cvt_pk_bf16(h1[2], h1[3]);
                *(u32x4*)rowp = w; }
    }
};

template <class Epi, class Sched, bool ALIGN_EPI = false, bool SP2 = false, bool F8 = false>
__device__ __forceinline__ void gemm_phase(PG8_LAS unsigned char* lds, const Gemm g, const Sched& S, const Epi& E, const int tid  ) {
    const int wid = __builtin_amdgcn_readfirstlane(tid >> 6), lane = tid & 63, wr = wid >> 2, wc = wid & 3, fr = lane & 15, fq = lane >> 4;
    const int K = F8 ? g.K / 2 : g.K, nt = K / BK;
    unsigned voffA[2], voffB[2];
#pragma unroll
    for (int i = 0; i < 2; ++i) { int R, C; stage_rc(tid * 16 + i * 8192, R, C); const int Rb = Epi::PERM ? ((R & ~31) + perm32(R & 31)) : R;
        voffA[i] = (unsigned)(R * K + C) * 2u; voffB[i] = (unsigned)(Rb * K + C) * 2u; }
    const size_t kstep = (size_t)(BK * 2);
    const size_t hstep = (size_t)HALF * K * 2;
    const size_t tstep = 2 * hstep;
    const unsigned ldsw = (unsigned)wid * 1024u;
    const int aoff = lds_byte(wr * 64 + fr, fq * 8), boff = lds_byte(wc * 32 + fr, fq * 8);
#define PG8_SA(b, h) (((b) * 2 + (h)) * HTB)
#define PG8_SB(b, h) ((4 + (b) * 2 + (h)) * HTB)
#define PG8_STAGE(bufoff, gbase, voff) do { _Pragma("unroll") for (int _i = 0; _i < 2; ++_i) \
        __builtin_amdgcn_global_load_lds((const unsigned*)((const char*)(gbase) + (voff)[_i]), (PG8_LAS unsigned*)(lds + (bufoff) + ldsw + _i * 8192), 16, 0, 0); } while (0)
#define PG8_LDA(dst, b, h) do { _Pragma("unroll") for (int m = 0; m < 4; ++m) { if constexpr (F8) { dst##8[m].lo = *(const PG8_LAS i32x4*)(lds + PG8_SA(b, h) + aoff + m * 2048); dst##8[m].hi = *(const PG8_LAS i32x4*)(lds + PG8_SA(b, h) + aoff + m * 2048 + 1024); } \
        else { _Pragma("unroll") for (int k = 0; k < 2; ++k) dst[m][k] = *(const PG8_LAS bf16x8*)(lds + PG8_SA(b, h) + aoff + m * 2048 + k * 1024); } } } while (0)
#define PG8_LDB(dst, b, h) do { _Pragma("unroll") for (int n = 0; n < 2; ++n) { if constexpr (F8) { dst##8[n].lo = *(const PG8_LAS i32x4*)(lds + PG8_SB(b, h) + boff + n * 2048); dst##8[n].hi = *(const PG8_LAS i32x4*)(lds + PG8_SB(b, h) + boff + n * 2048 + 1024); } \
        else { _Pragma("unroll") for (int k = 0; k < 2; ++k) dst[n][k] = *(const PG8_LAS bf16x8*)(lds + PG8_SB(b, h) + boff + n * 2048 + k * 1024); } } } while (0)
#define PG8_MMA(ai, bj, At, Bt) do { __builtin_amdgcn_s_setprio(1); _Pragma("unroll") for (int m = 0; m < 4; ++m) _Pragma("unroll") for (int n = 0; n < 2; ++n) { \
        if constexpr (F8) asm volatile("v_mfma_f32_16x16x128_f8f6f4 %0, %1, %2, %0" : "+v"(acc[ai][bj][m][n]) : "v"(Bt##8[n]), "v"(At##8[m]));   \
        else { _Pragma("unroll") for (int k = 0; k < 2; ++k) acc[ai][bj][m][n] = __builtin_amdgcn_mfma_f32_16x16x32_bf16(Bt[n][k], At[m][k], acc[ai][bj][m][n], 0, 0, 0); } } __builtin_amdgcn_s_setprio(0); } while (0)
#define PG8_WAIT_V(n) asm volatile("s_waitcnt vmcnt(" #n ")" ::: "memory")
#define PG8_WAIT_L(n) asm volatile("s_waitcnt lgkmcnt(" #n ")" ::: "memory")
#define PG8_BAR __builtin_amdgcn_s_barrier()
#define PG8_SCHED __builtin_amdgcn_sched_barrier(0)
    Unit cur, nxt; int ui = 0;
    if (!S.next(0, cur)) return;
    f32x4 acc[2][2][4][2];
#pragma unroll
    for (int a = 0; a < 2; ++a)
#pragma unroll
        for (int b = 0; b < 2; ++b)
#pragma unroll
            for (int m = 0; m < 4; ++m)
#pragma unroll
                for (int n = 0; n < 2; ++n) acc[a][b][m][n] = (f32x4){0.f, 0.f, 0.f, 0.f};
    bf16x8 At[4][2], B0[2][2], B1[2][2];
    i32x8 At8[4], B08[2], B18[2];
    const char* cA = (const char*)g.A + (size_t)cur.pm * tstep; const char* cB = (const char*)g.Bt + (size_t)cur.pn * tstep;
    S.a_ready(cur);
    if constexpr (SP2) {
        PG8_STAGE(PG8_SB(0, 0), cB, voffB); PG8_STAGE(PG8_SB(0, 1), cB + hstep, voffB); PG8_STAGE(PG8_SA(0, 0), cA, voffA); PG8_STAGE(PG8_SA(0, 1), cA + hstep, voffA);
        if (wr == 1) PG8_BAR;
        PG8_WAIT_V(2); PG8_BAR;
        PG8_STAGE(PG8_SB(1, 0), cB + kstep, voffB); PG8_STAGE(PG8_SA(1, 0), cA + kstep, voffA); PG8_STAGE(PG8_SB(1, 1), cB + hstep + kstep, voffB);
        PG8_WAIT_V(6); PG8_BAR;
    } else {
        PG8_STAGE(PG8_SB(0, 0), cB, voffB); PG8_STAGE(PG8_SA(0, 0), cA, voffA); PG8_STAGE(PG8_SB(0, 1), cB + hstep, voffB); PG8_STAGE(PG8_SA(0, 1), cA + hstep, voffA);
        if (wr == 1) PG8_BAR;
        PG8_WAIT_V(4); PG8_BAR;
        PG8_STAGE(PG8_SB(1, 0), cB + kstep, voffB); PG8_STAGE(PG8_SA(1, 0), cA + kstep, voffA); PG8_STAGE(PG8_SB(1, 1), cB + hstep + kstep, voffB);
        PG8_WAIT_V(6); PG8_BAR;
    }
    for (;;) {
        const bool has_next = S.next(ui + 1, nxt);
        const char* nA = has_next ? (const char*)g.A + (size_t)nxt.pm * tstep : cA; const char* nB = has_next ? (const char*)g.Bt + (size_t)nxt.pn * tstep : cB;
        for (int t = 0; t < nt; t += 2) {
            const bool last = (t == nt - 2);
            const char* a1 = cA + (size_t)(t + 1) * kstep;
            const char* a2 = last ? nA : cA + (size_t)(t + 2) * kstep; const char* b2 = last ? nB : cB + (size_t)(t + 2) * kstep;
            const char* a3 = a2 + kstep; const char* b3 = b2 + kstep;
            if (last && has_next) S.a_ready(nxt);
            if constexpr (SP2) {
            PG8_LDB(B0, 0, 0); PG8_LDB(B1, 0, 1); PG8_SCHED; PG8_LDA(At, 0, 0); PG8_STAGE(PG8_SA(1, 1), a1 + hstep, voffA);
            PG8_WAIT_V(8); PG8_WAIT_L(0); PG8_BAR; PG8_MMA(0, 0, At, B0); PG8_MMA(0, 1, At, B1); PG8_BAR; PG8_SCHED;
            PG8_LDA(At, 0, 1); PG8_STAGE(PG8_SB(0, 0), b2, voffB); PG8_STAGE(PG8_SB(0, 1), b2 + hstep, voffB); PG8_STAGE(PG8_SA(0, 0), a2, voffA);
            PG8_WAIT_V(8); PG8_WAIT_L(0); PG8_BAR; PG8_MMA(1, 0, At, B0); PG8_MMA(1, 1, At, B1); PG8_BAR; PG8_SCHED;
            PG8_LDB(B0, 1, 0); PG8_LDB(B1, 1, 1); PG8_SCHED; PG8_LDA(At, 1, 0); PG8_STAGE(PG8_SA(0, 1), a2 + hstep, voffA);
            PG8_WAIT_V(8); PG8_WAIT_L(0); PG8_BAR; PG8_MMA(0, 0, At, B0); PG8_MMA(0, 1, At, B1); PG8_BAR; PG8_SCHED;
            PG8_LDA(At, 1, 1); PG8_STAGE(PG8_SB(1, 0), b3, voffB); PG8_STAGE(PG8_SB(1, 1), b3 + hstep, voffB); PG8_STAGE(PG8_SA(1, 0), a3, voffA);
            PG8_WAIT_V(8); PG8_WAIT_L(0); PG8_BAR; PG8_MMA(1, 0, At, B0); PG8_MMA(1, 1, At, B1); PG8_BAR; PG8_SCHED;
            } else {
            PG8_LDB(B0, 0, 0); PG8_SCHED; PG8_LDA(At, 0, 0); PG8_STAGE(PG8_SA(1, 1), a1 + hstep, voffA);
            PG8_WAIT_L(8); PG8_BAR; PG8_WAIT_L(0); PG8_MMA(0, 0, At, B0); PG8_BAR; PG8_SCHED;
            PG8_LDB(B1, 0, 1); PG8_STAGE(PG8_SB(0, 0), b2, voffB);
            PG8_BAR; PG8_WAIT_L(0); PG8_MMA(0, 1, At, B1); PG8_BAR;
            PG8_LDA(At, 0, 1); PG8_STAGE(PG8_SA(0, 0), a2, voffA);
            PG8_BAR; PG8_WAIT_L(0); PG8_MMA(1, 0, At, B0); PG8_BAR; PG8_SCHED;
            PG8_STAGE(PG8_SB(0, 1), b2 + hstep, voffB);
            PG8_WAIT_V(6); PG8_BAR; PG8_MMA(1, 1, At, B1); PG8_BAR;
            PG8_LDB(B0, 1, 0); PG8_SCHED; PG8_LDA(At, 1, 0); PG8_STAGE(PG8_SA(0, 1), a2 + hstep, voffA);
            PG8_WAIT_L(8); PG8_BAR; PG8_WAIT_L(0); PG8_MMA(0, 0, At, B0); PG8_BAR; PG8_SCHED;
            PG8_LDB(B1, 1, 1); PG8_STAGE(PG8_SB(1, 0), b3, voffB);
            PG8_BAR; PG8_WAIT_L(0); PG8_MMA(0, 1, At, B1); PG8_BAR;
            PG8_LDA(At, 1, 1); PG8_STAGE(PG8_SA(1, 0), a3, voffA);
            PG8_BAR; PG8_WAIT_L(0); PG8_MMA(1, 0, At, B0); PG8_BAR; PG8_SCHED;
            PG8_STAGE(PG8_SB(1, 1), b3 + hstep, voffB);
            PG8_WAIT_V(6); PG8_BAR; PG8_MMA(1, 1, At, B1); PG8_BAR;
            }
        }
        if constexpr (F8) asm volatile("s_nop 15\n\ts_nop 15" ::: "memory");
        if constexpr (ALIGN_EPI) { if (wr == 0) PG8_BAR; }
        if constexpr (!Epi::AFTER_DRAIN) { E(acc, cur, wr, wc, fr, fq); S.done(cur); }
        if (!has_next) break;
#pragma unroll
        for (int a = 0; a < 2; ++a)
#pragma unroll
            for (int b = 0; b < 2; ++b)
#pragma unroll
                for (int m = 0; m < 4; ++m)
#pragma unroll
                    for (int n = 0; n < 2; ++n) acc[a][b][m][n] = (f32x4){0.f, 0.f, 0.f, 0.f};
        cur = nxt; cA = nA; cB = nB; ++ui;
        if constexpr (ALIGN_EPI) { if (wr == 1) PG8_BAR; }
    }
    PG8_WAIT_V(0);
    if constexpr (!ALIGN_EPI) { if (wr == 0) PG8_BAR; }
    PG8_BAR;
    if constexpr (Epi::AFTER_DRAIN) { E.fused(acc, cur, wr, wc, fr, fq, lds, wid, lane); S.done(cur); }
#undef PG8_SA
#undef PG8_SB
#undef PG8_STAGE
#undef PG8_LDA
#undef PG8_LDB
#undef PG8_MMA
#undef PG8_WAIT_V
#undef PG8_WAIT_L
#undef PG8_BAR
#undef PG8_SCHED
}
}

#ifndef PG8_SP2
#define PG8_SP2 true
#endif
namespace att {
using bf16 = __hip_bfloat16;
constexpr int D = 128, NW = 8, QBLK = 32, KVBLK = 64;
constexpr float SCALE = 0.088388347648318440f;
constexpr float THR = 8.f;
constexpr float LOG2E = 1.4426950408889634f;
constexpr size_t SHM_V = KVBLK * D * 2, SHM_K = KVBLK * D * 2, SHM_ATTN = 2 * SHM_V + 2 * SHM_K + NW * 64 * 4;
using bf16x8 = __attribute__((ext_vector_type(8))) short;
using s16x4  = __attribute__((ext_vector_type(4))) short;
using f32x16 = __attribute__((ext_vector_type(16))) float;
using u32x4  = __attribute__((ext_vector_type(4))) unsigned;
#define KSWZ(row, colB) ((row) * 256 + ((colB) ^ (((row) & 7) << 4)))
#define SBAR() __builtin_amdgcn_sched_barrier(0)
__device__ __forceinline__ int crow(int r, int hi) { return (r & 3) + 8 * (r >> 2) + 4 * hi; }
__device__ __forceinline__ unsigned cvtpk(float lo, float hi) { return pg8::cvt_pk_bf16(lo, hi); }
__device__ __forceinline__ void partialSM(f32x16& p0, f32x16& p1, float& m_reg, float& mn, float& alpha) {
  constexpr float C = SCALE * LOG2E;
  float pmax = p0[0]; for (int r = 1; r < 16; ++r) pmax = fmaxf(pmax, p0[r]); for (int r = 0; r < 16; ++r) pmax = fmaxf(pmax, p1[r]);
  { auto rr = __builtin_amdgcn_permlane32_swap(__float_as_uint(pmax), __float_as_uint(pmax), false, false);
    pmax = fmaxf(__uint_as_float(rr[0]), __uint_as_float(rr[1])); }
  if (__builtin_expect(__all(pmax - m_reg <= THR / SCALE), 1)) { mn = m_reg; alpha = 1.f; }
  else { mn = fmaxf(m_reg, pmax); alpha = __builtin_amdgcn_exp2f((m_reg - mn) * C); m_reg = mn; }
  float mnC = -mn * C;
  for (int r = 0; r < 16; ++r) p0[r] = fmaf(p0[r], C, mnC); for (int r = 0; r < 16; ++r) p1[r] = fmaf(p1[r], C, mnC);
  for (int r = 0; r < 16; ++r) p0[r] = __builtin_amdgcn_exp2f(p0[r]);
}
__device__ __forceinline__ void partialSM_win(f32x16& p0, f32x16& p1, float& m_reg, float& mn, float& alpha, float ef, float slope2) {
  constexpr float C = SCALE * LOG2E;
#pragma unroll
  for (int r = 0; r < 16; ++r) { const float o0 = (float)((r & 3) + 8 * (r >> 2));
    const float d0 = fabsf(ef + o0), d1 = fabsf(ef + (o0 + 32.f));
    const float t0 = fmaf(p0[r], C, -slope2 * d0), t1 = fmaf(p1[r], C, -slope2 * d1);
    p0[r] = d0 > 64.5f ? -1e30f : t0; p1[r] = d1 > 64.5f ? -1e30f : t1; }
  float pmax = p0[0]; for (int r = 1; r < 16; ++r) pmax = fmaxf(pmax, p0[r]); for (int r = 0; r < 16; ++r) pmax = fmaxf(pmax, p1[r]);
  { auto rr = __builtin_amdgcn_permlane32_swap(__float_as_uint(pmax), __float_as_uint(pmax), false, false);
    pmax = fmaxf(__uint_as_float(rr[0]), __uint_as_float(rr[1])); }
  if (__builtin_expect(__all(pmax - m_reg <= THR * LOG2E), 1)) { mn = m_reg; alpha = 1.f; }
  else { mn = fmaxf(m_reg, pmax); alpha = __builtin_amdgcn_exp2f(m_reg - mn); m_reg = mn; }
  for (int r = 0; r < 16; ++r) p0[r] = p0[r] - mn; for (int r = 0; r < 16; ++r) p1[r] = p1[r] - mn;
  for (int r = 0; r < 16; ++r) p0[r] = __builtin_amdgcn_exp2f(p0[r]);
}
__device__ __forceinline__ void finishSM(f32x16& p0, f32x16& p1, float alpha, float& l_reg, bf16x8& pa0, bf16x8& pa1, bf16x8& pa2, bf16x8& pa3) {
  for (int r = 0; r < 16; ++r) p1[r] = __builtin_amdgcn_exp2f(p1[r]);
  float ps = 0; for (int r = 0; r < 16; ++r) ps += p0[r]; for (int r = 0; r < 16; ++r) ps += p1[r];
  { auto rr = __builtin_amdgcn_permlane32_swap(__float_as_uint(ps), __float_as_uint(ps), false, false);
    ps = __uint_as_float(rr[0]) + __uint_as_float(rr[1]); }
  l_reg = l_reg * alpha + ps;
#define PK4(P, BASE, OUT) do { unsigned a0 = cvtpk(P[BASE + 0], P[BASE + 1]), a1 = cvtpk(P[BASE + 2], P[BASE + 3]);   \
    unsigned b0 = cvtpk(P[BASE + 4], P[BASE + 5]), b1 = cvtpk(P[BASE + 6], P[BASE + 7]);                              \
    auto r0 = __builtin_amdgcn_permlane32_swap(a0, b0, false, false); auto r1 = __builtin_amdgcn_permlane32_swap(a1, b1, false, false); \
    u32x4 w = {r0[0], r1[0], r0[1], r1[1]}; OUT = *reinterpret_cast<bf16x8*>(&w); } while (0)
  PK4(p0, 0, pa0); PK4(p0, 8, pa1); PK4(p1, 0, pa2); PK4(p1, 8, pa3);
#undef PK4
}
__device__ __forceinline__ void qkt(f32x16& p0, f32x16& p1, const bf16* Ks, const bf16x8* qr, int r32, int hi) {
  p0 = f32x16{}; p1 = f32x16{};
  for (int d0 = 0; d0 < 8; ++d0) { int cb = (d0 * 16 + hi * 8) * 2;
    bf16x8 b0 = *reinterpret_cast<const bf16x8*>((const char*)Ks + KSWZ(r32, cb));
    bf16x8 b1 = *reinterpret_cast<const bf16x8*>((const char*)Ks + KSWZ(32 + r32, cb));
    p0 = __builtin_amdgcn_mfma_f32_32x32x16_bf16(b0, qr[d0], p0, 0, 0, 0);
    p1 = __builtin_amdgcn_mfma_f32_32x32x16_bf16(b1, qr[d0], p1, 0, 0, 0); }
}
__device__ __forceinline__ int v_st(int k, int c) { const int kk = (k & ~0xC) | ((k & 4) << 1) | ((k & 8) >> 1); return ((kk >> 3) * 4 + (c >> 5)) * 512 + ((kk & 7) * 32 + (c & 31)) * 2; }
__device__ __forceinline__ int v_rd_base(int lane) { return ((lane & 3) << 3) | (((lane >> 2) & 3) << 6) | (((lane >> 4) & 1) << 5) | (((lane >> 5) & 1) << 8); }
constexpr int v_rd_off(int d0, int ks, int half) { return d0 * 512 + ks * 4096 + half * 2048; }
template <int OFF> __device__ __forceinline__ s16x4 tr_read(int vb) {
  s16x4 r; asm volatile("ds_read_b64_tr_b16 %0, %1 offset:%2" : "=&v"(r) : "v"(vb), "i"(OFF) : "memory"); return r;
}
template <int D0> __device__ __forceinline__ void pv_one(f32x16& od, int vb, bf16x8 pa0, bf16x8 pa1, bf16x8 pa2, bf16x8 pa3) {
  const s16x4 l0 = tr_read<v_rd_off(D0, 0, 0)>(vb), h0 = tr_read<v_rd_off(D0, 0, 1)>(vb), l1 = tr_read<v_rd_off(D0, 1, 0)>(vb), h1 = tr_read<v_rd_off(D0, 1, 1)>(vb);
  const s16x4 l2 = tr_read<v_rd_off(D0, 2, 0)>(vb), h2 = tr_read<v_rd_off(D0, 2, 1)>(vb), l3 = tr_read<v_rd_off(D0, 3, 0)>(vb), h3 = tr_read<v_rd_off(D0, 3, 1)>(vb);
  asm volatile("s_waitcnt lgkmcnt(0)" ::: "memory"); SBAR();
#define PK(L, H) (bf16x8){L[0], L[1], L[2], L[3], H[0], H[1], H[2], H[3]}
  od = __builtin_amdgcn_mfma_f32_32x32x16_bf16(pa0, PK(l0, h0), od, 0, 0, 0);
  od = __builtin_amdgcn_mfma_f32_32x32x16_bf16(pa1, PK(l1, h1), od, 0, 0, 0);
  od = __builtin_amdgcn_mfma_f32_32x32x16_bf16(pa2, PK(l2, h2), od, 0, 0, 0);
  od = __builtin_amdgcn_mfma_f32_32x32x16_bf16(pa3, PK(l3, h3), od, 0, 0, 0);
#undef PK
}
__device__ __forceinline__ void pv_d0(f32x16* o, int vb, bf16x8 pa0, bf16x8 pa1, bf16x8 pa2, bf16x8 pa3) {
  pv_one<0>(o[0], vb, pa0, pa1, pa2, pa3); pv_one<1>(o[1], vb, pa0, pa1, pa2, pa3); pv_one<2>(o[2], vb, pa0, pa1, pa2, pa3); pv_one<3>(o[3], vb, pa0, pa1, pa2, pa3);
}

template <bool WIN, bool OUT8 = false>
__device__ __forceinline__ void attn_unit(const bf16* __restrict__ Qb, long ldq, const bf16* __restrict__ Kh, const bf16* __restrict__ Vh, long ldk,
                                          bf16* __restrict__ Ob, long ldo, int NT, char* lds, int e0, float slope2, float* __restrict__ lse_out, long ldl, const int tid, const float oscale = 1.f) {
  const int wid = tid >> 6, lane = tid & 63, r32 = lane & 31, hi = lane >> 5;
  bf16* V_lds = (bf16*)lds; bf16* K_lds = (bf16*)(lds + 2 * SHM_V);
  float* ws = (float*)(lds + 2 * SHM_V + 2 * SHM_K) + wid * 64; float* li_l = ws; float* al_l = ws + 32;
  float m_reg = WIN ? -1e20f : -1e30f, l_reg = 0; f32x16 o[4] = {}; bf16x8 qr[8];
  const bf16* Qw = Qb + (long)(wid * QBLK + r32) * ldq + hi * 8;
#pragma unroll
  for (int d0 = 0; d0 < 8; ++d0) qr[d0] = *reinterpret_cast<const bf16x8*>(Qw + d0 * 16);
  const int sr = tid >> 4, sc = (tid & 15) * 8, vst0 = v_st(sr, sc), vst1 = v_st(32 + sr, sc);
  const int vb0 = (int)(uintptr_t)V_lds + v_rd_base(lane);
  float ef = (float)(e0 + 4 * hi - (wid * QBLK + r32));
  struct { bf16x8 vs0, vs1, ks0, ks1; } sr_[2];
  const unsigned voff0 = (unsigned)(sr * (int)ldk + sc) * 2u, voff1 = voff0 + (unsigned)(32 * (int)ldk) * 2u;
#define SLOAD(i, k0) do { const char* vt_ = (const char*)Vh + (size_t)(k0) * (size_t)ldk * 2; const char* kt_ = (const char*)Kh + (size_t)(k0) * (size_t)ldk * 2; \
    sr_[i].vs0 = *reinterpret_cast<const bf16x8*>(vt_ + voff0); sr_[i].vs1 = *reinterpret_cast<const bf16x8*>(vt_ + voff1); \
    sr_[i].ks0 = *reinterpret_cast<const bf16x8*>(kt_ + voff0); sr_[i].ks1 = *reinterpret_cast<const bf16x8*>(kt_ + voff1); } while (0)
#define SWRITE(b, i) do { *(bf16x8*)((char*)V_lds + (b) * SHM_V + vst0) = sr_[i].vs0;          \
    *(bf16x8*)((char*)V_lds + (b) * SHM_V + vst1) = sr_[i].vs1; int kc = sc * 2;               \
    *(bf16x8*)((char*)K_lds + (b) * SHM_K + KSWZ(sr, kc)) = sr_[i].ks0;                       \
    *(bf16x8*)((char*)K_lds + (b) * SHM_K + KSWZ(32 + sr, kc)) = sr_[i].ks1; } while (0)
#define SWAIT() do { asm volatile("s_waitcnt vmcnt(4)" ::: "memory"); } while (0)
#define RESC(a) do { if (__any((a) < 1.f)) { if (hi == 0) al_l[r32] = (a); asm volatile("s_waitcnt lgkmcnt(0)" ::: "memory"); \
    for (int d = 0; d < 4; ++d) for (int r = 0; r < 16; ++r) o[d][r] *= al_l[crow(r, hi)]; } } while (0)
#define PSM(P0, P1, MN, AL) do { if constexpr (WIN) { partialSM_win(P0, P1, m_reg, MN, AL, ef, slope2); ef += 64.f; } else partialSM(P0, P1, m_reg, MN, AL); } while (0)
  f32x16 pA0, pA1, pB0, pB1; float mnA, mnB, alA, alB; bf16x8 pa0, pa1, pa2, pa3;
  constexpr int SE = 0, SO = 1;
  SLOAD(SE, 0); asm volatile("s_waitcnt vmcnt(0)" ::: "memory"); SWRITE(0, SE); __syncthreads();
  qkt(pA0, pA1, K_lds, qr, r32, hi); PSM(pA0, pA1, mnA, alA);
  SLOAD(SO, KVBLK); if (2 < NT) SLOAD(SE, 2 * KVBLK);
  SWAIT(); SWRITE(1, SO); __syncthreads();
  for (int j = 1; j + 1 < NT; j += 2) {
    SBAR(); qkt(pB0, pB1, (bf16*)((char*)K_lds + SHM_K), qr, r32, hi);
    finishSM(pA0, pA1, alA, l_reg, pa0, pa1, pa2, pa3); SBAR();
    SLOAD(SO, (j + 2) * KVBLK); SBAR();
    pv_d0(o, vb0, pa0, pa1, pa2, pa3); PSM(pB0, pB1, mnB, alB);
    __syncthreads(); SWAIT(); SWRITE(0, SE);
    RESC(alB); __syncthreads();
    SBAR(); qkt(pA0, pA1, K_lds, qr, r32, hi);
    finishSM(pB0, pB1, alB, l_reg, pa0, pa1, pa2, pa3); SBAR();
    if (j + 3 < NT) SLOAD(SE, (j + 3) * KVBLK); SBAR();
    pv_d0(o, vb0 + (int)SHM_V, pa0, pa1, pa2, pa3); PSM(pA0, pA1, mnA, alA);
    __syncthreads(); SWAIT(); SWRITE(1, SO);
    RESC(alA); __syncthreads();
  }
  SBAR(); qkt(pB0, pB1, (bf16*)((char*)K_lds + SHM_K), qr, r32, hi);
  finishSM(pA0, pA1, alA, l_reg, pa0, pa1, pa2, pa3); SBAR();
  pv_d0(o, vb0, pa0, pa1, pa2, pa3); PSM(pB0, pB1, mnB, alB);
  __syncthreads(); RESC(alB);
  finishSM(pB0, pB1, alB, l_reg, pa0, pa1, pa2, pa3); SBAR();
  pv_d0(o, vb0 + (int)SHM_V, pa0, pa1, pa2, pa3);
  if (hi == 0) li_l[r32] = l_reg; asm volatile("s_waitcnt lgkmcnt(0)" ::: "memory");
  if constexpr (WIN) { if (hi == 0) lse_out[(long)(wid * QBLK + r32) * ldl] = (m_reg + __builtin_amdgcn_logf(l_reg)) * 0.6931471805599453f; }
  float rli[16];
#pragma unroll
  for (int r = 0; r < 16; ++r) rli[r] = __builtin_amdgcn_rcpf(li_l[crow(r, hi)]);
  if constexpr (OUT8) {
    unsigned char* Ow = (unsigned char*)Ob + (long)(wid * QBLK) * ldo;
#pragma unroll
    for (int r = 0; r < 16; ++r) { int orow = crow(r, hi); const float s_ = rli[r] * oscale;
      for (int d0 = 0; d0 < 4; ++d0) { const float v_ = o[d0][r] * s_; Ow[(long)orow * ldo + d0 * 32 + r32] = (unsigned char)__builtin_amdgcn_cvt_pk_fp8_f32(v_, v_, 0, false); } }
  } else {
  bf16* Ow = Ob + (long)(wid * QBLK) * ldo;
#pragma unroll
  for (int r = 0; r < 16; ++r) { int orow = crow(r, hi);
    for (int d0 = 0; d0 < 4; ++d0) Ow[(long)orow * ldo + d0 * 32 + r32] = __float2bfloat16(o[d0][r] * rli[r]); }
  }
#undef SLOAD
#undef SWRITE
#undef SWAIT
#undef RESC
#undef PSM
}
#undef KSWZ
#undef SBAR
}
#define LAS __attribute__((address_space(3)))
#define XB_TMO      128
#define XB_XCNT(j)  (256  + 64 * (j))
#define XB_XSUB(j)  (1280 + 64 * (j))
#define XB_XGEN(j)  (2304 + 64 * (j))
#define XB_TOP      3328
#define XB_TOPGEN   3392
#define XCD_BAR_WORDS 3456
#define XB_SPIN_CAP (1u << 18)

__device__ __forceinline__ unsigned xb_ld(unsigned* p)              { return __hip_atomic_load(p, __ATOMIC_RELAXED, __HIP_MEMORY_SCOPE_AGENT); }
__device__ __forceinline__ unsigned xb_add(unsigned* p, unsigned v) { return __hip_atomic_fetch_add(p, v, __ATOMIC_RELAXED, __HIP_MEMORY_SCOPE_AGENT); }
__device__ __forceinline__ unsigned xb_xcc_id() { return (unsigned)__builtin_amdgcn_s_getreg((3 << 11) | 20) & 0xFu; }
#define XB_SPIN(cond, bar) do { unsigned _sp = 0; while (cond) { __builtin_amdgcn_s_sleep(1); \
    if ((++_sp & 255u) == 0u) { if (xb_ld(&(bar)[XB_TMO])) break; if (_sp > XB_SPIN_CAP) { atomicAdd(&(bar)[XB_TMO], 1u); break; } } } } while (0)

struct XcdBarrier {
    unsigned* bar; unsigned x;
    volatile LAS unsigned* st;
};

__device__ __forceinline__ XcdBarrier xcd_barrier_post(unsigned* bar, volatile LAS unsigned* st, bool leader) {
    XcdBarrier b; b.bar = bar; b.x = xb_xcc_id(); b.st = st;
    if (leader) (void)xb_add(&bar[XB_XCNT(b.x)], 1u);
    return b;
}
__device__ __forceinline__ void xcd_barrier_complete(unsigned* bar, unsigned x, unsigned& nloc, unsigned& nx) {
    const unsigned G = gridDim.x * gridDim.y * gridDim.z;
    unsigned sum, cnt, mine, sp = 0u;
    for (;;) {
        sum = 0u; cnt = 0u; mine = 0u;
#pragma unroll
        for (unsigned j = 0; j < 16; ++j) { const unsigned c = xb_ld(&bar[XB_XCNT(j)]); sum += c; cnt += (c > 0u) ? 1u : 0u; mine = (j == x) ? c : mine; }
        if (sum == G) break;
        __builtin_amdgcn_s_sleep(1);
        if ((++sp & 255u) == 0u) { if (xb_ld(&bar[XB_TMO])) break; if (sp > XB_SPIN_CAP) { atomicAdd(&bar[XB_TMO], 1u); break; } }
    }
    nloc = mine > 0u ? mine : 1u; nx = cnt > 0u ? cnt : 1u;
}

__device__ __forceinline__ void xcd_barrier(const XcdBarrier& b, bool leader) {
    asm volatile("s_waitcnt vmcnt(0)" ::: "memory");
    __syncthreads();
    if (leader) {
        unsigned* bar = b.bar;
        __builtin_amdgcn_s_waitcnt(0);
        unsigned nloc = b.st[0], nx = b.st[1];
        if (nloc == 0u) { xcd_barrier_complete(bar, b.x, nloc, nx); b.st[0] = nloc; b.st[1] = nx; }
        const unsigned old = xb_add(&bar[XB_XSUB(b.x)], 1u);
        const unsigned gen = old / nloc;
        if (old + 1u == (gen + 1u) * nloc) {
            __builtin_amdgcn_fence(__ATOMIC_RELEASE, "agent");
            asm volatile("s_waitcnt vmcnt(0)" ::: "memory");
            const unsigned og = xb_add(&bar[XB_TOP], 1u);
            const unsigned tg = og / nx;
            if (og + 1u == (tg + 1u) * nx) xb_add(&bar[XB_TOPGEN], 1u);
            else XB_SPIN(xb_ld(&bar[XB_TOPGEN]) == tg, bar);
            __builtin_amdgcn_fence(__ATOMIC_ACQUIRE, "agent");
            xb_add(&bar[XB_XGEN(b.x)], 1u);
            asm volatile("s_waitcnt vmcnt(0)" ::: "memory");
        } else {
            XB_SPIN(xb_ld(&bar[XB_XGEN(b.x)]) == gen, bar);
            __builtin_amdgcn_fence(__ATOMIC_ACQUIRE, "agent");
            asm volatile("s_waitcnt vmcnt(0)" ::: "memory");
        }
    }
    __syncthreads();
}

typedef unsigned short bf16u;
typedef unsigned v4u __attribute__((ext_vector_type(4)));
typedef unsigned v2u __attribute__((ext_vector_type(2)));
typedef float f32x4 __attribute__((ext_vector_type(4)));

constexpr int M = 16384, DM = 2048, SEQ = 4096, NIN = 10240, NQKV = 6144, NGATE = 4096, FF = 5632;
constexpr float ALPHA = 1.189207115002721f;
constexpr float RMS_EPS = 1e-6f, LN_EPS = 1e-5f;
constexpr float OA8_SCALE = 256.f, OB8_SCALE = 8.f, MP8_SCALE = 32.f;
constexpr float W8_SCALE = 64.f;
constexpr int NTHR = 512, NWAVES = 8;
constexpr int LDS_BYTES = 131072 + 2048;

constexpr size_t MiB = 1u << 20;
constexpr size_t WS_WGU = 1 * MiB, WS_WDN = 45 * MiB, WS_WOUT = 67 * MiB, WS_WPA = 75 * MiB, WS_WPB = 79 * MiB;
constexpr size_t WS_WIN = 81 * MiB, WS_XB = 121 * MiB, WS_QKV = 185 * MiB, WS_G = 377 * MiB, WS_END = 505 * MiB;
constexpr size_t WS_OA = 81 * MiB, WS_OBP = 113 * MiB, WS_LSE = 161 * MiB, WS_OB = 162 * MiB;
constexpr size_t WS_MP = 185 * MiB, WS_X1B = 249 * MiB, WS_H = 313 * MiB;

struct Params {
    const float *x, *w_in, *b_gate, *qn, *kn, *wpa, *wpb, *wout, *ln1g, *ln1b, *wg, *wu, *wd, *ln2g, *ln2b;
    float* out; unsigned char* ws;
};

__device__ __forceinline__ unsigned f2bf(float f) { unsigned u = __builtin_bit_cast(unsigned, f); return (u + 0x7fffu + ((u >> 16) & 1u)) >> 16; }
__device__ __forceinline__ unsigned pk2(float lo, float hi) { return f2bf(lo) | (f2bf(hi) << 16); }
__device__ __forceinline__ float bf2f(unsigned short h) { return __uint_as_float((unsigned)h << 16); }
__device__ __forceinline__ float wave_sum(float v) {
#pragma unroll
    for (int o = 1; o < 64; o <<= 1) v += __shfl_xor(v, o);
    return v;
}

__device__ __forceinline__ void transpose_item(const float* W, int K, int N, bf16u* WT, int k0, int n0, int drow0, LAS float* scr, int lane) {
#pragma unroll 8
    for (int i = 0; i < 32; ++i) { const int kk = 2 * i + (lane >> 5); scr[kk * 33 + (lane & 31)] = W[(size_t)(k0 + kk) * N + n0 + (lane & 31)]; }
    asm volatile("s_waitcnt lgkmcnt(0)" ::: "memory");
    const int c = lane & 7;
#pragma unroll
    for (int j = 0; j < 4; ++j) { const int n = (lane >> 3) + 8 * j; const LAS float* s = scr + (8 * c) * 33 + n;
        v4u o; o.x = pk2(s[0 * 33], s[1 * 33]); o.y = pk2(s[2 * 33], s[3 * 33]); o.z = pk2(s[4 * 33], s[5 * 33]); o.w = pk2(s[6 * 33], s[7 * 33]);
        *(v4u*)(WT + (size_t)(drow0 + n) * K + k0 + 8 * c) = o; }
    asm volatile("s_waitcnt lgkmcnt(0)" ::: "memory");
}

using pg8::pk4_fp8;
__device__ __forceinline__ void transpose_item8(const float* W, int K, int N, unsigned char* WT, int k0, int n0, int drow0, LAS float* scr, int lane, float scale) {
#pragma unroll 8
    for (int i = 0; i < 32; ++i) { const int kk = 2 * i + (lane >> 5); scr[kk * 33 + (lane & 31)] = W[(size_t)(k0 + kk) * N + n0 + (lane & 31)]; }
    asm volatile("s_waitcnt lgkmcnt(0)" ::: "memory");
    const int c = lane & 3;
#pragma unroll
    for (int j = 0; j < 2; ++j) { const int n = (lane >> 2) + 16 * j; const LAS float* s = scr + (16 * c) * 33 + n;
        v4u o;
        o.x = pk4_fp8(s[0 * 33] * scale, s[1 * 33] * scale, s[2 * 33] * scale, s[3 * 33] * scale);
        o.y = pk4_fp8(s[4 * 33] * scale, s[5 * 33] * scale, s[6 * 33] * scale, s[7 * 33] * scale);
        o.z = pk4_fp8(s[8 * 33] * scale, s[9 * 33] * scale, s[10 * 33] * scale, s[11 * 33] * scale);
        o.w = pk4_fp8(s[12 * 33] * scale, s[13 * 33] * scale, s[14 * 33] * scale, s[15 * 33] * scale);
        *(v4u*)(WT + (size_t)(drow0 + n) * K + k0 + 16 * c) = o; }
    asm volatile("s_waitcnt lgkmcnt(0)" ::: "memory");
}

__device__ __forceinline__ void ln_row(const float* src, const float* g, const float* b, float* dst, bf16u* dstb, int lane) {
    const f32x4* xr = (const f32x4*)src + lane;
    f32x4 v[8]; float s = 0.f;
#pragma unroll
    for (int j = 0; j < 8; ++j) { v[j] = xr[64 * j]; s += (v[j].x + v[j].y) + (v[j].z + v[j].w); }
    const float mean = wave_sum(s) * (1.f / DM); float s2 = 0.f;
#pragma unroll
    for (int j = 0; j < 8; ++j) { v[j] = v[j] - mean; s2 += (v[j].x * v[j].x + v[j].y * v[j].y) + (v[j].z * v[j].z + v[j].w * v[j].w); }
    const float rstd = 1.f / sqrtf(wave_sum(s2) * (1.f / DM) + LN_EPS);
    f32x4* o4 = (f32x4*)dst + lane;
#pragma unroll
    for (int j = 0; j < 8; ++j) { const f32x4 gg = ((const f32x4*)g)[64 * j + lane], bb = ((const f32x4*)b)[64 * j + lane];
        const f32x4 y = v[j] * rstd * gg + bb; o4[64 * j] = y;
        if (dstb) { v2u w; w.x = pk2(y.x, y.y); w.y = pk2(y.z, y.w); ((v2u*)dstb)[64 * j + lane] = w; } }
}

#ifndef REP_P1
#define REP_P1 1
#endif
#ifndef REP_P7
#define REP_P7 1
#endif
#ifndef REP_P0
#define REP_P0 1
#endif
#ifndef REP_A
#define REP_A 1
#endif
#ifndef REP_B
#define REP_B 1
#endif
#ifndef REP_SYNC
#define REP_SYNC 0
#endif
#ifndef REP_LN
#define REP_LN 1
#endif
__global__ void __launch_bounds__(NTHR, 2) mega_fwd(Params p) {
    extern __shared__ __attribute__((aligned(16))) unsigned char lds[];
    cg::grid_group grid = cg::this_grid();
    const int wave = __builtin_amdgcn_readfirstlane((int)threadIdx.x >> 6);
#define FRESH_LANE(L) int L; asm volatile("v_mbcnt_lo_u32_b32 %0, -1, 0\n\tv_mbcnt_hi_u32_b32 %0, -1, %0" : "=v"(L))
    const int G = gridDim.x, bx = blockIdx.x;
    const int vcu = (G % 8 == 0) ? (bx % 8) * (G / 8) + bx / 8 : bx;
    const int gw = vcu * NWAVES + wave, NGW = G * NWAVES;
    unsigned char* ws = p.ws;
    bf16u* WGU = (bf16u*)(ws + WS_WGU); bf16u* WDN = (bf16u*)(ws + WS_WDN); bf16u* WOUT = (bf16u*)(ws + WS_WOUT);
    bf16u* WPA = (bf16u*)(ws + WS_WPA); bf16u* WPB = (bf16u*)(ws + WS_WPB); bf16u* WINT = (bf16u*)(ws + WS_WIN);
    bf16u* XB = (bf16u*)(ws + WS_XB); bf16u* QKV = (bf16u*)(ws + WS_QKV); bf16u* GB = (bf16u*)(ws + WS_G);
    bf16u* OA = (bf16u*)(ws + WS_OA); bf16u* OBP = (bf16u*)(ws + WS_OBP); float* LSE = (float*)(ws + WS_LSE); bf16u* OB = (bf16u*)(ws + WS_OB);
    bf16u* MP = (bf16u*)(ws + WS_MP); bf16u* X1B = (bf16u*)(ws + WS_X1B); bf16u* HB = (bf16u*)(ws + WS_H);
    LAS unsigned char* ldsl = (LAS unsigned char*)lds;
    unsigned* barw = (unsigned*)ws;
    volatile LAS unsigned* MISC = (volatile LAS unsigned*)(ldsl + 131072 + 1024);
    { FRESH_LANE(l0); if (wave == 0 && l0 < 2) MISC[l0] = 0u; if (bx == 0) for (int i = wave * 64 + l0; i < XCD_BAR_WORDS; i += NTHR) __hip_atomic_store(barw + i, 0u, __ATOMIC_RELAXED, __HIP_MEMORY_SCOPE_AGENT); }
#define SEAM() do { FRESH_LANE(ls_); xcd_barrier(xbar, wave == 0 && ls_ == 0); } while (0)

    for (int rep_ = 0; rep_ < REP_P0; ++rep_) {
        FRESH_LANE(lane); const int tid = wave * 64 + lane;
        LAS float* scr = (LAS float*)(ldsl + wave * 8704);
        constexpr int I_IN = 32 * 320, I_G = 32 * 176, I_U = I_G, I_D = 88 * 64, I_O = 32 * 64, I_PA = 16 * 64, I_PB = 8 * 64;
        constexpr int NITEMS = I_IN + I_G + I_U + I_D + I_O + I_PA + I_PB;
        for (int it = gw; it < NITEMS; it += NGW) {
            int r = it;
            if (r < I_IN) { const int kb = r / 320, nb = r % 320; transpose_item8(p.w_in, 2048, NIN, (unsigned char*)WINT, 64 * kb, 32 * nb, 32 * nb, scr, lane, W8_SCALE); continue; } r -= I_IN;
            if (r < I_G) { const int kb = r / 176, nb = r % 176, n0 = 32 * nb; transpose_item(p.wg, 2048, FF, WGU, 64 * kb, n0, 256 * (n0 >> 7) + (n0 & 127), scr, lane); continue; } r -= I_G;
            if (r < I_U) { const int kb = r / 176, nb = r % 176, n0 = 32 * nb; transpose_item(p.wu, 2048, FF, WGU, 64 * kb, n0, 256 * (n0 >> 7) + 128 + (n0 & 127), scr, lane); continue; } r -= I_U;
            if (r < I_D) { const int kb = r / 64, nb = r % 64; transpose_item(p.wd, FF, 2048, WDN, 64 * kb, 32 * nb, 32 * nb, scr, lane); continue; } r -= I_D;
            if (r < I_O) { const int kb = r / 64, nb = r % 64; transpose_item8(p.wout, 2048, 2048, (unsigned char*)WOUT, 64 * kb, 32 * nb, 32 * nb, scr, lane, W8_SCALE); continue; } r -= I_O;
            if (r < I_PA) { const int kb = r / 64, nb = r % 64; transpose_item8(p.wpa, 1024, 2048, (unsigned char*)WPA, 64 * kb, 32 * nb, 32 * nb, scr, lane, W8_SCALE); continue; } r -= I_PA;
            { const int kb = r / 64, nb = r % 64; transpose_item8(p.wpb, 512, 2048, (unsigned char*)WPB, 64 * kb, 32 * nb, 32 * nb, scr, lane, W8_SCALE); }
        }
        const size_t n16 = (size_t)M * DM / 16;
        for (size_t i = (size_t)bx * NTHR + tid; i < n16; i += (size_t)G * NTHR) {
            const f32x4 a = ((const f32x4*)p.x)[4 * i], b = ((const f32x4*)p.x)[4 * i + 1], c = ((const f32x4*)p.x)[4 * i + 2], d = ((const f32x4*)p.x)[4 * i + 3];
            v4u o; o.x = pk4_fp8(a.x, a.y, a.z, a.w); o.y = pk4_fp8(b.x, b.y, b.z, b.w); o.z = pk4_fp8(c.x, c.y, c.z, c.w); o.w = pk4_fp8(d.x, d.y, d.z, d.w);
            ((v4u*)XB)[i] = o;
        }
    }
    grid.sync();
    XcdBarrier xbar; { FRESH_LANE(l1); xbar = xcd_barrier_post(barw, MISC, wave == 0 && l1 == 0); }

    for (int rep_ = 0; rep_ < REP_P1; ++rep_) {
        pg8::Gemm g{XB, WINT, M, NIN, DM}; pg8::StaticOrder S; S.init(M, NIN, G, bx);
        pg8::EpiQKVG E{QKV, GB, p.b_gate, 1.f / W8_SCALE};
        FRESH_LANE(lane); pg8::gemm_phase<pg8::EpiQKVG, pg8::StaticOrder, true, PG8_SP2, true>(ldsl, g, S, E, wave * 64 + lane);
    }
    SEAM();

    {
        FRESH_LANE(lane);
        const int i = lane & 31, h2 = lane >> 5;
        const float freq = __builtin_amdgcn_exp2f(-(float)i * (13.287712379549449f / 32.f));
        const float gq0 = p.qn[i], gq1 = p.qn[i + 32], gq2 = p.qn[i + 64], gq3 = p.qn[i + 96];
        const float gk0 = p.kn[i], gk1 = p.kn[i + 32], gk2 = p.kn[i + 64], gk3 = p.kn[i + 96];
        for (int t = gw; t < M; t += NGW) {
            const int pos = t & (SEQ - 1), rid = pos >> 6, cid = pos & 63;
            float ar = (float)rid * freq * 0.15915494309189535f, ac = (float)cid * freq * 0.15915494309189535f;
            ar -= floorf(ar); ac -= floorf(ac);
            const float sr = __builtin_amdgcn_sinf(ar), cr = __builtin_amdgcn_cosf(ar), sc = __builtin_amdgcn_sinf(ac), cc = __builtin_amdgcn_cosf(ac);
#pragma unroll
            for (int it = 0; it < 5; ++it) {
                const int head = 2 * it + h2; bf16u* hp = QKV + (size_t)t * NQKV + head * 128;
                float a = bf2f(hp[i]), b = bf2f(hp[i + 32]), c = bf2f(hp[i + 64]), d = bf2f(hp[i + 96]);
                float ss = (a * a + b * b) + (c * c + d * d);
#pragma unroll
                for (int o = 1; o < 32; o <<= 1) ss += __shfl_xor(ss, o);
                const float rs = 1.f / sqrtf(ss * (1.f / 128.f) + RMS_EPS);
                const bool isq = head < 8;
                a *= rs * (isq ? gq0 : gk0); b *= rs * (isq ? gq1 : gk1); c *= rs * (isq ? gq2 : gk2); d *= rs * (isq ? gq3 : gk3);
                hp[i] = (bf16u)f2bf(a * cr - b * sr); hp[i + 32] = (bf16u)f2bf(b * cr + a * sr);
                hp[i + 64] = (bf16u)f2bf(c * cc - d * sc); hp[i + 96] = (bf16u)f2bf(d * cc + c * sc);
            }
        }
    }
    SEAM();

    {
        FRESH_LANE(lane); const int tid = wave * 64 + lane;
        const att::bf16* Q = (const att::bf16*)QKV;
        for (int rep_ = 0; rep_ < REP_A; ++rep_)
        for (int u = vcu; u < 512; u += G) {
            const int bk = u >> 6, b = bk >> 1, kvh = bk & 1, rem = u & 63, hq = kvh * 4 + (rem >> 4), qblk = rem & 15;
            const size_t row0 = (size_t)b * SEQ;
            att::attn_unit<false, true>(Q + (row0 + qblk * 256) * NQKV + hq * 128, NQKV, Q + row0 * NQKV + 1024 + kvh * 128, Q + row0 * NQKV + 1280 + kvh * 128, NQKV,
                                  (att::bf16*)((unsigned char*)OA + (row0 + qblk * 256) * 1024 + hq * 128), 1024, SEQ / 64, (char*)lds, 0, 0.f, nullptr, 0, tid, OA8_SCALE);
        }
        FRESH_LANE(laneb); const int tidb = wave * 64 + laneb;
        for (int rep_ = 0; rep_ < REP_B; ++rep_)
        for (int u = vcu; u < 768; u += G) {
            const int g = u >> 8, idx = u & 255, b = idx >> 6, h = (idx >> 4) & 3, sub = idx & 15;
            const int dil = g == 0 ? 1 : (g == 1 ? 4 : 16), lsub = SEQ / dil;
            const int c = g == 0 ? 0 : (g == 1 ? (sub >> 2) : sub), qblk = g == 0 ? sub : (g == 1 ? (sub & 3) : 0);
            const int q0 = qblk * 256, NT = g == 2 ? 4 : 6;
            int kv0 = q0 - 64; if (kv0 > lsub - 64 * NT) kv0 = lsub - 64 * NT; if (kv0 < 0) kv0 = 0;
            const int gh = g * 4 + h;
            const float slope2 = __builtin_amdgcn_exp2f(-8.f * (float)(gh + 1) / 12.f) * (float)dil * 1.4426950408889634f;
            const size_t row0 = (size_t)b * SEQ + c;
            att::attn_unit<true>(Q + (row0 + (size_t)dil * q0) * NQKV + 1536 + gh * 128, (long)dil * NQKV,
                                 Q + (row0 + (size_t)dil * kv0) * NQKV + 3072 + gh * 128, Q + (row0 + (size_t)dil * kv0) * NQKV + 4608 + gh * 128, (long)dil * NQKV,
                                 (att::bf16*)OBP + (size_t)g * M * 512 + (row0 + (size_t)dil * q0) * 512 + h * 128, (long)dil * 512, NT, (char*)lds, kv0 - q0, slope2,
                                 LSE + (size_t)g * M * 4 + (row0 + (size_t)dil * q0) * 4 + h, (long)dil * 4, tidb);
        }
    }
    SEAM();

    {
        FRESH_LANE(lane);
        for (int t = gw; t < M; t += NGW) {
            const int h = lane >> 4;
            const float l0 = LSE[(size_t)t * 4 + h], l1 = LSE[(size_t)M * 4 + (size_t)t * 4 + h], l2 = LSE[(size_t)2 * M * 4 + (size_t)t * 4 + h];
            const float mx = fmaxf(l0, fmaxf(l1, l2));
            float w0 = __expf(l0 - mx), w1 = __expf(l1 - mx), w2 = __expf(l2 - mx); const float inv = 1.f / (w0 + w1 + w2); w0 *= inv; w1 *= inv; w2 *= inv;
            const v4u a = ((const v4u*)(OBP + (size_t)t * 512))[lane], b = ((const v4u*)(OBP + (size_t)M * 512 + (size_t)t * 512))[lane], c = ((const v4u*)(OBP + (size_t)2 * M * 512 + (size_t)t * 512))[lane];
            float vv[8];
#pragma unroll
            for (int e = 0; e < 4; ++e) {
                vv[2 * e] = (w0 * __uint_as_float(a[e] << 16) + w1 * __uint_as_float(b[e] << 16) + w2 * __uint_as_float(c[e] << 16)) * OB8_SCALE;
                vv[2 * e + 1] = (w0 * __uint_as_float(a[e] & 0xffff0000u) + w1 * __uint_as_float(b[e] & 0xffff0000u) + w2 * __uint_as_float(c[e] & 0xffff0000u)) * OB8_SCALE; }
            v2u o; o.x = pk4_fp8(vv[0], vv[1], vv[2], vv[3]); o.y = pk4_fp8(vv[4], vv[5], vv[6], vv[7]);
            ((v2u*)((unsigned char*)OB + (size_t)t * 512))[lane] = o;
        }
        pg8::Gemm g{OA, WPA, M, DM, 1024}; pg8::StaticOrder S; S.init(M, DM, G, bx);
        pg8::EpiGateA E{p.out, GB, 1.f / (OA8_SCALE * W8_SCALE)};
        FRESH_LANE(lane2); pg8::gemm_phase<pg8::EpiGateA, pg8::StaticOrder, true, PG8_SP2, true>(ldsl, g, S, E, wave * 64 + lane2);
    }
    SEAM();

    {
        pg8::Gemm g{OB, WPB, M, DM, 512}; pg8::StaticOrder S; S.init(M, DM, G, bx);
        pg8::EpiGateB E{p.out, GB, (unsigned char*)MP, 1.f / (OB8_SCALE * W8_SCALE), MP8_SCALE};
        FRESH_LANE(lane2); pg8::gemm_phase<pg8::EpiGateB, pg8::StaticOrder, true, PG8_SP2, true>(ldsl, g, S, E, wave * 64 + lane2);
    }
    SEAM();

    {
        pg8::Gemm g{MP, WOUT, M, DM, DM}; pg8::StaticOrder S; S.init(M, DM, G, bx);
        pg8::EpiResid E{p.x, p.out, ALPHA, 1.f / (MP8_SCALE * W8_SCALE)};
        FRESH_LANE(lane2); pg8::gemm_phase<pg8::EpiResid, pg8::StaticOrder, true, PG8_SP2, true>(ldsl, g, S, E, wave * 64 + lane2);
    }
    SEAM();

    for (int rep_ = 0; rep_ < REP_SYNC; ++rep_) SEAM();
    for (int rep_ = 1; rep_ < REP_LN; ++rep_) { FRESH_LANE(lane); for (int t = gw; t < M; t += NGW) ln_row(p.out + (size_t)t * DM, p.ln1g, p.ln1b, (float*)(ws + WS_H) + (size_t)t * DM, X1B + (size_t)t * DM, lane); }
    { FRESH_LANE(lane); for (int t = gw; t < M; t += NGW) ln_row(p.out + (size_t)t * DM, p.ln1g, p.ln1b, p.out + (size_t)t * DM, X1B + (size_t)t * DM, lane); }
    SEAM();

    for (int rep_ = 0; rep_ < REP_P7; ++rep_) {
        pg8::Gemm g{X1B, WGU, M, 2 * FF, DM}; pg8::StaticOrder S; S.init(M, 2 * FF, G, bx);
        pg8::EpiSwiGLU E{HB};
        FRESH_LANE(lane2); pg8::gemm_phase<pg8::EpiSwiGLU, pg8::StaticOrder, true, PG8_SP2>(ldsl, g, S, E, wave * 64 + lane2);
    }
    SEAM();

    {
        pg8::Gemm g{HB, WDN, M, DM, FF}; pg8::StaticOrder S; S.init(M, DM, G, bx);
        pg8::EpiResid E{p.out, p.out, ALPHA, 1.f};
        FRESH_LANE(lane2); pg8::gemm_phase<pg8::EpiResid, pg8::StaticOrder, true, PG8_SP2>(ldsl, g, S, E, wave * 64 + lane2);
    }
    SEAM();

    { FRESH_LANE(lane); for (int t = gw; t < M; t += NGW) ln_row(p.out + (size_t)t * DM, p.ln2g, p.ln2b, p.out + (size_t)t * DM, nullptr, lane); }
}

extern "C" void kernel_launch(void* const* d_in, const int* in_sizes, int n_in, void* d_out, int out_size, void* d_ws, size_t ws_size, hipStream_t stream) {
    static int grid = 0;
    if (grid == 0) {
        if (n_in != 15 || in_sizes[0] != M * DM || out_size != M * DM || ws_size < WS_END) {
            fprintf(stderr, "kernel_launch: shape mismatch n_in %d in0 %d out %d ws %zu (need %zu)\n", n_in, n_in > 0 ? in_sizes[0] : -1, out_size, ws_size, (size_t)WS_END); grid = -1; return; }
        int dev = 0, cus = 0, per_cu = 0;
        hipGetDevice(&dev); hipDeviceGetAttribute(&cus, hipDeviceAttributeMultiprocessorCount, dev);
        if (hipFuncSetAttribute((const void*)mega_fwd, hipFuncAttributeMaxDynamicSharedMemorySize, LDS_BYTES) != hipSuccess) { fprintf(stderr, "kernel_launch: hipFuncSetAttribute failed\n"); grid = -1; return; }
        if (hipOccupancyMaxActiveBlocksPerMultiprocessor(&per_cu, (const void*)mega_fwd, NTHR, LDS_BYTES) != hipSuccess || per_cu < 1) { fprintf(stderr, "kernel_launch: occupancy query gave %d\n", per_cu); per_cu = 1; }
        (void)hipGetLastError();
        grid = cus * per_cu;
    }
    if (grid < 0) return;
    Params p{};
    p.x = (const float*)d_in[0]; p.w_in = (const float*)d_in[1]; p.b_gate = (const float*)d_in[2]; p.qn = (const float*)d_in[3]; p.kn = (const float*)d_in[4];
    p.wpa = (const float*)d_in[5]; p.wpb = (const float*)d_in[6]; p.wout = (const float*)d_in[7]; p.ln1g = (const float*)d_in[8]; p.ln1b = (const float*)d_in[9];
    p.wg = (const float*)d_in[10]; p.wu = (const float*)d_in[11]; p.wd = (const float*)d_in[12]; p.ln2g = (const float*)d_in[13]; p.ln2b = (const float*)d_in[14];
    p.out = (float*)d_out; p.ws = (unsigned char*)d_ws;
    void* args[] = {&p};
    hipError_t e = hipLaunchCooperativeKernel((const void*)mega_fwd, dim3(grid), dim3(NTHR), args, LDS_BYTES, stream);
    if (e != hipSuccess) fprintf(stderr, "kernel_launch: cooperative launch failed: %s (grid %d)\n", hipGetErrorString(e), grid);
}
```
